# Optimizing an MI355X kernel written in HIP

```python
import math
import jax, jax.numpy as jnp
from jax import lax
import numpy as np

D_MODEL = 2048
BATCH = 4
SEQ = 2048
DEPTH = 1
DEC_BATCH = 1
DEC_SEQ = 16384
PAST_LEN = 128

N_META = 16
GRID_W = 64
Q_BLOCK = 128
EPS = 1e-6

A_QK_DIM = 64
A_V_DIM = 2 * A_QK_DIM
A_HEADS = (D_MODEL // 2) // A_V_DIM
A_WIDTH = A_HEADS * A_V_DIM
B_HEAD_DIM = 128
B_HEADS = (D_MODEL // 2) // B_HEAD_DIM
B_KV_HEADS = B_HEADS // 4
B_GROUP = B_HEADS // B_KV_HEADS
B_WIDTH = B_HEADS * B_HEAD_DIM
ROPE_THETA = 10000.0
MIX_WIDTH = A_WIDTH + B_WIDTH

A_Q_COLS = 2 * A_HEADS * A_QK_DIM
A_K_COLS = 2 * A_HEADS * A_QK_DIM
A_V_COLS = A_HEADS * A_V_DIM
B_Q_COLS = B_HEADS * B_HEAD_DIM
B_K_COLS = B_KV_HEADS * B_HEAD_DIM
B_V_COLS = B_KV_HEADS * B_HEAD_DIM
IN_WIDTH = A_Q_COLS + A_K_COLS + A_V_COLS + B_Q_COLS + B_K_COLS + B_V_COLS
SPLIT_POINTS = (A_Q_COLS,
                A_Q_COLS + A_K_COLS,
                A_Q_COLS + A_K_COLS + A_V_COLS,
                A_Q_COLS + A_K_COLS + A_V_COLS + B_Q_COLS,
                A_Q_COLS + A_K_COLS + A_V_COLS + B_Q_COLS + B_K_COLS)

REL_BUCKETS = 32
REL_MAX_DIST = 128

D_FF = 256 * ((8 * D_MODEL // 3 + 255) // 256)

kernel_name = "hymba_diffattn_axialgqa_macaron_encoder"


def rms_norm(x, g):
    xf = x.astype(jnp.float32)
    y = xf * lax.rsqrt(jnp.mean(xf * xf, axis=-1, keepdims=True) + EPS)
    return (y * g.astype(jnp.float32)).astype(x.dtype)


def swiglu_ffn(x, w_in, w_out):
    gate, up = jnp.split(x @ w_in, 2, axis=-1)
    return (jax.nn.silu(gate) * up) @ w_out


def t5_bucket(rel):
    half = REL_BUCKETS // 2
    max_exact = half // 2
    n = jnp.abs(rel)
    sign_off = jnp.where(rel > 0, half, 0)
    nf = jnp.maximum(n, 1).astype(jnp.float32)
    large = max_exact + (jnp.log(nf / max_exact) / math.log(REL_MAX_DIST / max_exact)
                         * (half - max_exact)).astype(jnp.int32)
    large = jnp.minimum(large, half - 1)
    return sign_off + jnp.where(n < max_exact, n, large)


def sweep_query_blocks(block_fn, q_parts):
    L = q_parts[0].shape[-2]
    n_tok = L - N_META
    nb = n_tok // Q_BLOCK
    meta_out = block_fn(tuple(q[..., :N_META, :] for q in q_parts), jnp.arange(N_META))

    def to_blocks(q):
        r = q[..., N_META:, :]
        r = r.reshape(r.shape[:-2] + (nb, Q_BLOCK, r.shape[-1]))
        return jnp.moveaxis(r, -3, 0)

    pos = (N_META + jnp.arange(n_tok)).reshape(nb, Q_BLOCK)
    outs = lax.map(lambda a: block_fn(a[0], a[1]), (tuple(to_blocks(q) for q in q_parts), pos))
    outs = jnp.moveaxis(outs, 0, -3)
    outs = outs.reshape(outs.shape[:-3] + (n_tok, outs.shape[-1]))
    return jnp.concatenate([meta_out, outs], axis=-2)


def diff_attention(aq, ak, av, lam_params, lam_init, subln_g, rel_table):
    B, L, _ = aq.shape
    q = aq.reshape(B, L, A_HEADS, 2, A_QK_DIM).transpose(0, 2, 3, 1, 4)
    k = ak.reshape(B, L, A_HEADS, 2, A_QK_DIM).transpose(0, 2, 3, 1, 4)
    v = av.reshape(B, L, A_HEADS, A_V_DIM).transpose(0, 2, 1, 3)
    k1, k2 = k[:, :, 0], k[:, :, 1]
    lp = lam_params.astype(jnp.float32)
    lam = jnp.exp(jnp.sum(lp[0] * lp[1])) - jnp.exp(jnp.sum(lp[2] * lp[3])) + lam_init
    scale = A_QK_DIM ** -0.5
    k_pos = jnp.arange(L)

    def block_fn(qs, q_pos):
        q1b, q2b = qs
        bias = rel_table.astype(jnp.float32)[t5_bucket(k_pos[None, :] - q_pos[:, None])]
        bias = jnp.moveaxis(bias, -1, 0)[None]
        s1 = jnp.einsum('bhqd,bhkd->bhqk', q1b, k1).astype(jnp.float32) * scale + bias
        s2 = jnp.einsum('bhqd,bhkd->bhqk', q2b, k2).astype(jnp.float32) * scale + bias
        attn = jax.nn.softmax(s1, axis=-1) - lam * jax.nn.softmax(s2, axis=-1)
        return jnp.einsum('bhqk,bhkd->bhqd', attn.astype(v.dtype), v)

    out = sweep_query_blocks(block_fn, (q[:, :, 0], q[:, :, 1]))
    out = rms_norm(out, subln_g) * (1.0 - lam_init)
    return out.transpose(0, 2, 1, 3).reshape(B, L, A_WIDTH)


def apply_rope(x, cos, sin):
    xp = x.astype(jnp.float32).reshape(x.shape[:-1] + (x.shape[-1] // 2, 2))
    x0, x1 = xp[..., 0], xp[..., 1]
    out = jnp.stack([x0 * cos - x1 * sin, x0 * sin + x1 * cos], axis=-1)
    return out.reshape(x.shape).astype(x.dtype)


def axial_rope_tables(rows):
    row = jnp.repeat(jnp.arange(rows), GRID_W).astype(jnp.float32)
    col = jnp.tile(jnp.arange(GRID_W), rows).astype(jnp.float32)
    axis_dim = B_HEAD_DIM // 2
    freqs = ROPE_THETA ** (-jnp.arange(0, axis_dim, 2, dtype=jnp.float32) / axis_dim)
    ang = jnp.concatenate([row[:, None] * freqs, col[:, None] * freqs], axis=-1)
    ang = jnp.concatenate([jnp.zeros((N_META, B_HEAD_DIM // 2), jnp.float32), ang], axis=0)
    return jnp.cos(ang), jnp.sin(ang)


def gqa_axial_attention(bq, bk, bv, qk_g, cos, sin):
    B, L, _ = bq.shape
    q = bq.reshape(B, L, B_KV_HEADS, B_GROUP, B_HEAD_DIM).transpose(0, 2, 3, 1, 4)
    k = bk.reshape(B, L, B_KV_HEADS, B_HEAD_DIM).transpose(0, 2, 1, 3)
    v = bv.reshape(B, L, B_KV_HEADS, B_HEAD_DIM).transpose(0, 2, 1, 3)
    q = apply_rope(rms_norm(q, qk_g[0]), cos, sin)
    k = apply_rope(rms_norm(k, qk_g[1]), cos, sin)
    scale = B_HEAD_DIM ** -0.5

    def block_fn(qs, q_pos):
        (qb,) = qs
        s = jnp.einsum('bngqd,bnkd->bngqk', qb, k).astype(jnp.float32) * scale
        p = jax.nn.softmax(s, axis=-1)
        return jnp.einsum('bngqk,bnkd->bngqd', p.astype(v.dtype), v)

    out = sweep_query_blocks(block_fn, (q,))
    return out.transpose(0, 3, 1, 2, 4).reshape(B, L, B_WIDTH)


def encoder_trunk(x, rows, meta_tokens, rel_bias_table, ffn1_norm, ffn1_w_in, ffn1_w_out,
                  mix_norm, w_in, diff_lambda, diff_subln, qk_norm, w_out,
                  ffn2_norm, ffn2_w_in, ffn2_w_out, final_norm):
    B = x.shape[0]
    meta = jnp.broadcast_to(meta_tokens.astype(x.dtype)[None], (B, N_META, D_MODEL))
    h = jnp.concatenate([meta, x], axis=1)
    cos, sin = axial_rope_tables(rows)
    for l in range(DEPTH):
        lam_init = 0.8 - 0.6 * math.exp(-0.3 * l)
        h = h + 0.5 * swiglu_ffn(rms_norm(h, ffn1_norm[l]), ffn1_w_in[l], ffn1_w_out[l])
        u = rms_norm(h, mix_norm[l])
        aq, ak, av, bq, bk, bv = jnp.split(u @ w_in[l], SPLIT_POINTS, axis=-1)
        ya = diff_attention(aq, ak, av, diff_lambda[l], lam_init, diff_subln[l], rel_bias_table)
        yb = gqa_axial_attention(bq, bk, bv, qk_norm[l], cos, sin)
        h = h + jnp.concatenate([ya, yb], axis=-1) @ w_out[l]
        h = h + 0.5 * swiglu_ffn(rms_norm(h, ffn2_norm[l]), ffn2_w_in[l], ffn2_w_out[l])
    h = rms_norm(h, final_norm)
    return h[:, N_META:]


def setup_inputs(seed: int = 0) -> dict:
    key = jax.random.key(seed)
    ks = jax.random.split(key, 17)
    f32 = jnp.float32

    def nrm(k, shape, scale):
        return jax.random.normal(k, shape, f32) * scale

    def gain(k, shape):
        return 1.0 + 0.02 * jax.random.normal(k, shape, f32)

    return {
        "x_prompt": nrm(ks[0], (BATCH, SEQ, D_MODEL), 1.0),
        "x_sample": nrm(ks[1], (DEC_BATCH, DEC_SEQ, D_MODEL), 1.0),
        "meta_tokens": nrm(ks[2], (N_META, D_MODEL), 1.0),
        "rel_bias_table": nrm(ks[3], (REL_BUCKETS, A_HEADS), 0.5),
        "ffn1_norm": gain(ks[4], (DEPTH, D_MODEL)),
        "ffn1_w_in": nrm(ks[5], (DEPTH, D_MODEL, 2 * D_FF), D_MODEL ** -0.5),
        "ffn1_w_out": nrm(ks[6], (DEPTH, D_FF, D_MODEL), D_FF ** -0.5),
        "mix_norm": gain(ks[7], (DEPTH, D_MODEL)),
        "w_in": nrm(ks[8], (DEPTH, D_MODEL, IN_WIDTH), D_MODEL ** -0.5),
        "diff_lambda": nrm(ks[9], (DEPTH, 4, A_QK_DIM), 0.1),
        "diff_subln": gain(ks[10], (DEPTH, A_V_DIM)),
        "qk_norm": gain(ks[11], (DEPTH, 2, B_HEAD_DIM)),
        "w_out": nrm(ks[12], (DEPTH, MIX_WIDTH, D_MODEL), MIX_WIDTH ** -0.5),
        "ffn2_norm": gain(ks[13], (DEPTH, D_MODEL)),
        "ffn2_w_in": nrm(ks[14], (DEPTH, D_MODEL, 2 * D_FF), D_MODEL ** -0.5),
        "ffn2_w_out": nrm(ks[15], (DEPTH, D_FF, D_MODEL), D_FF ** -0.5),
        "final_norm": gain(ks[16], (D_MODEL,)),
    }


def reference(x_prompt, x_sample, meta_tokens, rel_bias_table, ffn1_norm, ffn1_w_in, ffn1_w_out,
              mix_norm, w_in, diff_lambda, diff_subln, qk_norm, w_out,
              ffn2_norm, ffn2_w_in, ffn2_w_out, final_norm):
    rows_prompt = x_prompt.shape[1] // GRID_W
    rows_sample = x_sample.shape[1] // GRID_W
    y_prompt = encoder_trunk(x_prompt, rows_prompt, meta_tokens, rel_bias_table, ffn1_norm,
                             ffn1_w_in, ffn1_w_out, mix_norm, w_in, diff_lambda, diff_subln,
                             qk_norm, w_out, ffn2_norm, ffn2_w_in, ffn2_w_out, final_norm)
    y_sample = encoder_trunk(x_sample, rows_sample, meta_tokens, rel_bias_table, ffn1_norm,
                             ffn1_w_in, ffn1_w_out, mix_norm, w_in, diff_lambda, diff_subln,
                             qk_norm, w_out, ffn2_norm, ffn2_w_in, ffn2_w_out, final_norm)
    return (y_prompt, y_sample)
```

```cpp
#include <hip/hip_runtime.h>
#include <hip/hip_cooperative_groups.h>
#include <cstdio>
#include <cstdint>
#include <cmath>
namespace cg = cooperative_groups;
#ifndef MK_PER_PHASE
#define MK_PER_PHASE 0
#endif
__device__ __forceinline__ int ltid() { int t = threadIdx.x; asm volatile("" : "+v"(t)); return t; }
#define LAS __attribute__((address_space(3)))
namespace pg8 {
#define PG8_LAS __attribute__((address_space(3)))
typedef unsigned short bf16_t;
typedef short bf16x8 __attribute__((ext_vector_type(8)));
typedef float f32x4 __attribute__((ext_vector_type(4)));
typedef unsigned u32x4 __attribute__((ext_vector_type(4)));
constexpr int BM = 256, BK = 64, HALF = 128, HTB = HALF * BK * 2  , STAGE_BYTES = 8 * HTB, NXCD = 8, WGM = 4;

__host__ __device__ __forceinline__ int lds_byte(int r, int c) { const int st = (r >> 4) * 2 + (c >> 5), rr = r & 15, cc = c & 31, ob = rr * 64 + cc * 2; return st * 1024 + (ob ^ (((ob >> 9) & 1) << 5)); }
__host__ __device__ __forceinline__ void stage_rc(int b, int& R, int& C) { const int st = b / 1024, sb = b % 1024, swz = sb ^ (((sb >> 9) & 1) << 5); R = (st >> 1) * 16 + swz / 64; C = (st & 1) * 32 + (swz % 64) / 2; }
__host__ __device__ __forceinline__ int perm32(int rho) { const int n = rho >> 4, i = rho & 15; return 8 * (i >> 2) + 4 * n + (i & 3); }

struct Unit { int pm, pn; };
struct Gemm { const bf16_t* A; const bf16_t* Bt; int M, N, K, Kloop; };

struct StaticOrder {
    int nM, nN, nwg, G, c;
    __host__ __device__ void init(int M, int N, int G_, int c_) { nM = M / BM; nN = N / BM; nwg = nM * nN; G = G_; c = c_; }
    __host__ __device__ bool next(int i, Unit& u) const {
        const long L = (long)i * G + c; if (L >= nwg) return false;
        int wgid = (int)L; { const int q = nwg / NXCD, r = nwg % NXCD, xcd = wgid % NXCD, off = wgid / NXCD; wgid = (xcd < r ? xcd * (q + 1) : r * (q + 1) + (xcd - r) * q) + off; }
        const int nig = WGM * nN, gid = wgid / nig, fm = gid * WGM, gsz = (nM - fm) < WGM ? (nM - fm) : WGM;
        u.pm = fm + ((wgid % nig) % gsz); u.pn = (wgid % nig) / gsz; return true;
    }
    __device__ __forceinline__ size_t offA(const Unit& u, size_t tstep) const { return (size_t)u.pm * tstep; }
    __device__ __forceinline__ size_t offB(const Unit& u, size_t tstep) const { return (size_t)u.pn * tstep; }
    __device__ __forceinline__ void a_ready(const Unit&) const {}
    __device__ __forceinline__ void done(const Unit&) const {}
};
struct SplitOrder {
    int nunits, G, c, nN, ksbytes;
    __host__ __device__ void init(int N, int nsplit, int KS, int G_, int c_) { nN = N / BM; nunits = nN * nsplit; G = G_; c = c_; ksbytes = KS * 2; }
    __host__ __device__ bool next(int i, Unit& u) const { const long L = (long)i * G + c; if (L >= nunits) return false; u.pm = (int)L / nN; u.pn = (int)L % nN; return true; }
    __device__ __forceinline__ size_t offA(const Unit& u, size_t) const { return (size_t)u.pm * ksbytes; }
    __device__ __forceinline__ size_t offB(const Unit& u, size_t tstep) const { return (size_t)u.pn * tstep + (size_t)u.pm * ksbytes; }
    __device__ __forceinline__ void a_ready(const Unit&) const {}
    __device__ __forceinline__ void done(const Unit&) const {}
};
__device__ __forceinline__ unsigned cvt_pk_bf16(float lo, float hi) { unsigned r; asm volatile("v_cvt_pk_bf16_f32 %0, %1, %2" : "=v"(r) : "v"(lo), "v"(hi)); return r; }
typedef float f32x2 __attribute__((ext_vector_type(2)));
template <class Epi, class Sched, bool ALIGN_EPI = false, bool SP2 = false>
__device__ __forceinline__ void gemm_phase(PG8_LAS unsigned char* lds, const Gemm g, const Sched& S, const Epi& E) {
    const int tid = ltid(), wid = __builtin_amdgcn_readfirstlane(tid >> 6), lane = tid & 63, wr = wid >> 2, wc = wid & 3, fr = lane & 15, fq = lane >> 4;
    const int K = g.K  , nt = g.Kloop / BK  ;
    unsigned voffA[2], voffB[2];
#pragma unroll
    for (int i = 0; i < 2; ++i) { int R, C; stage_rc(tid * 16 + i * 8192, R, C); const int Rb = Epi::PERM ? ((R & ~31) + perm32(R & 31)) : R;
        voffA[i] = (unsigned)(R * K + C) * 2u; voffB[i] = (unsigned)(Rb * K + C) * 2u; }
    const size_t kstep = (size_t)(BK * 2);
    const size_t hstep = (size_t)HALF * K * 2;
    const size_t tstep = 2 * hstep;
    const unsigned ldsw = (unsigned)wid * 1024u;
    const int aoff = lds_byte(wr * 64 + fr, fq * 8), boff = lds_byte(wc * 32 + fr, fq * 8);
#define PG8_SA(b, h) (((b) * 2 + (h)) * HTB)
#define PG8_SB(b, h) ((4 + (b) * 2 + (h)) * HTB)
#define PG8_STAGE(bufoff, gbase, voff) do { _Pragma("unroll") for (int _i = 0; _i < 2; ++_i) \
        __builtin_amdgcn_global_load_lds((const unsigned*)((const char*)(gbase) + (voff)[_i]), (PG8_LAS unsigned*)(lds + (bufoff) + ldsw + _i * 8192), 16, 0, 0); } while (0)
#define PG8_LDA(dst, b, h) do { _Pragma("unroll") for (int m = 0; m < 4; ++m) _Pragma("unroll") for (int k = 0; k < 2; ++k) dst[m][k] = *(const PG8_LAS bf16x8*)(lds + PG8_SA(b, h) + aoff + m * 2048 + k * 1024); } while (0)
#define PG8_LDB(dst, b, h) do { _Pragma("unroll") for (int n = 0; n < 2; ++n) _Pragma("unroll") for (int k = 0; k < 2; ++k) dst[n][k] = *(const PG8_LAS bf16x8*)(lds + PG8_SB(b, h) + boff + n * 2048 + k * 1024); } while (0)
#define PG8_MMA(ai, bj, At, Bt) do { __builtin_amdgcn_s_setprio(1); _Pragma("unroll") for (int m = 0; m < 4; ++m) _Pragma("unroll") for (int n = 0; n < 2; ++n) _Pragma("unroll") for (int k = 0; k < 2; ++k) \
        acc[ai][bj][m][n] = __builtin_amdgcn_mfma_f32_16x16x32_bf16(Bt[n][k], At[m][k], acc[ai][bj][m][n], 0, 0, 0); __builtin_amdgcn_s_setprio(0); } while (0)
#define PG8_WAIT_V(n) asm volatile("s_waitcnt vmcnt(" #n ")" ::: "memory")
#define PG8_WAIT_L(n) asm volatile("s_waitcnt lgkmcnt(" #n ")" ::: "memory")
#define PG8_BAR __builtin_amdgcn_s_barrier()
#define PG8_SCHED __builtin_amdgcn_sched_barrier(0)
    Unit cur, nxt; int ui = 0;
    if (!S.next(0, cur)) return;
    f32x4 acc[2][2][4][2];
#pragma unroll
    for (int a = 0; a < 2; ++a)
#pragma unroll
        for (int b = 0; b < 2; ++b)
#pragma unroll
            for (int m = 0; m < 4; ++m)
#pragma unroll
                for (int n = 0; n < 2; ++n) { float z_ = 0.f; asm volatile("" : "+v"(z_)); acc[a][b][m][n] = (f32x4){z_, z_, z_, z_}; }
    bf16x8 At[4][2], B0[2][2], B1[2][2];
    { short zs_ = 0; asm volatile("" : "+v"(zs_)); const bf16x8 zq_ = {zs_, zs_, zs_, zs_, zs_, zs_, zs_, zs_};
#pragma unroll
      for (int m = 0; m < 4; ++m) { At[m][0] = zq_; At[m][1] = zq_; }
#pragma unroll
      for (int n = 0; n < 2; ++n) { B0[n][0] = zq_; B0[n][1] = zq_; B1[n][0] = zq_; B1[n][1] = zq_; } }
    const char* cA = (const char*)g.A + S.offA(cur, tstep); const char* cB = (const char*)g.Bt + S.offB(cur, tstep);
    S.a_ready(cur);
    if constexpr (SP2) {
        PG8_STAGE(PG8_SB(0, 0), cB, voffB); PG8_STAGE(PG8_SB(0, 1), cB + hstep, voffB); PG8_STAGE(PG8_SA(0, 0), cA, voffA); PG8_STAGE(PG8_SA(0, 1), cA + hstep, voffA);
        if (wr == 1) PG8_BAR;
        PG8_WAIT_V(2); PG8_BAR;
        PG8_STAGE(PG8_SB(1, 0), cB + kstep, voffB); PG8_STAGE(PG8_SA(1, 0), cA + kstep, voffA); PG8_STAGE(PG8_SB(1, 1), cB + hstep + kstep, voffB);
        PG8_WAIT_V(6); PG8_BAR;
    } else {
        PG8_STAGE(PG8_SB(0, 0), cB, voffB); PG8_STAGE(PG8_SA(0, 0), cA, voffA); PG8_STAGE(PG8_SB(0, 1), cB + hstep, voffB); PG8_STAGE(PG8_SA(0, 1), cA + hstep, voffA);
        if (wr == 1) PG8_BAR;
        PG8_WAIT_V(4); PG8_BAR;
        PG8_STAGE(PG8_SB(1, 0), cB + kstep, voffB); PG8_STAGE(PG8_SA(1, 0), cA + kstep, voffA); PG8_STAGE(PG8_SB(1, 1), cB + hstep + kstep, voffB);
        PG8_WAIT_V(6); PG8_BAR;
    }
    for (;;) {
        const bool has_next = S.next(ui + 1, nxt);
        const char* nA = has_next ? (const char*)g.A + S.offA(nxt, tstep) : cA; const char* nB = has_next ? (const char*)g.Bt + S.offB(nxt, tstep) : cB;
        for (int t = 0; t < nt; t += 2) {
            const bool last = (t == nt - 2);
            const char* a1 = cA + (size_t)(t + 1) * kstep;
            const char* a2 = last ? nA : cA + (size_t)(t + 2) * kstep; const char* b2 = last ? nB : cB + (size_t)(t + 2) * kstep;
            const char* a3 = a2 + kstep; const char* b3 = b2 + kstep;
            if (last && has_next) S.a_ready(nxt);
            if constexpr (SP2) {
            PG8_LDB(B0, 0, 0); PG8_LDB(B1, 0, 1); PG8_SCHED; PG8_LDA(At, 0, 0); PG8_STAGE(PG8_SA(1, 1), a1 + hstep, voffA);
            PG8_WAIT_V(8); PG8_WAIT_L(0); PG8_BAR; PG8_MMA(0, 0, At, B0); PG8_MMA(0, 1, At, B1); PG8_BAR; PG8_SCHED;
            PG8_LDA(At, 0, 1); PG8_STAGE(PG8_SB(0, 0), b2, voffB); PG8_STAGE(PG8_SB(0, 1), b2 + hstep, voffB); PG8_STAGE(PG8_SA(0, 0), a2, voffA);
            PG8_WAIT_V(8); PG8_WAIT_L(0); PG8_BAR; PG8_MMA(1, 0, At, B0); PG8_MMA(1, 1, At, B1); PG8_BAR; PG8_SCHED;
            PG8_LDB(B0, 1, 0); PG8_LDB(B1, 1, 1); PG8_SCHED; PG8_LDA(At, 1, 0); PG8_STAGE(PG8_SA(0, 1), a2 + hstep, voffA);
            PG8_WAIT_V(8); PG8_WAIT_L(0); PG8_BAR; PG8_MMA(0, 0, At, B0); PG8_MMA(0, 1, At, B1); PG8_BAR; PG8_SCHED;
            PG8_LDA(At, 1, 1); PG8_STAGE(PG8_SB(1, 0), b3, voffB); PG8_STAGE(PG8_SB(1, 1), b3 + hstep, voffB); PG8_STAGE(PG8_SA(1, 0), a3, voffA);
            PG8_WAIT_V(8); PG8_WAIT_L(0); PG8_BAR; PG8_MMA(1, 0, At, B0); PG8_MMA(1, 1, At, B1); PG8_BAR; PG8_SCHED;
            } else {
            PG8_LDB(B0, 0, 0); PG8_SCHED; PG8_LDA(At, 0, 0); PG8_STAGE(PG8_SA(1, 1), a1 + hstep, voffA);
            PG8_WAIT_L(8); PG8_BAR; PG8_WAIT_L(0); PG8_MMA(0, 0, At, B0); PG8_BAR; PG8_SCHED;
            PG8_LDB(B1, 0, 1); PG8_STAGE(PG8_SB(0, 0), b2, voffB);
            PG8_BAR; PG8_WAIT_L(0); PG8_MMA(0, 1, At, B1); PG8_BAR;
            PG8_LDA(At, 0, 1); PG8_STAGE(PG8_SA(0, 0), a2, voffA);
            PG8_BAR; PG8_WAIT_L(0); PG8_MMA(1, 0, At, B0); PG8_BAR; PG8_SCHED;
            PG8_STAGE(PG8_SB(0, 1), b2 + hstep, voffB);
            PG8_WAIT_V(6); PG8_BAR; PG8_MMA(1, 1, At, B1); PG8_BAR;
            PG8_LDB(B0, 1, 0); PG8_SCHED; PG8_LDA(At, 1, 0); PG8_STAGE(PG8_SA(0, 1), a2 + hstep, voffA);
            PG8_WAIT_L(8); PG8_BAR; PG8_WAIT_L(0); PG8_MMA(0, 0, At, B0); PG8_BAR; PG8_SCHED;
            PG8_LDB(B1, 1, 1); PG8_STAGE(PG8_SB(1, 0), b3, voffB);
            PG8_BAR; PG8_WAIT_L(0); PG8_MMA(0, 1, At, B1); PG8_BAR;
            PG8_LDA(At, 1, 1); PG8_STAGE(PG8_SA(1, 0), a3, voffA);
            PG8_BAR; PG8_WAIT_L(0); PG8_MMA(1, 0, At, B0); PG8_BAR; PG8_SCHED;
            PG8_STAGE(PG8_SB(1, 1), b3 + hstep, voffB);
            PG8_WAIT_V(6); PG8_BAR; PG8_MMA(1, 1, At, B1); PG8_BAR;
            }
        }
        if constexpr (ALIGN_EPI) { if (wr == 0) PG8_BAR; }
        if constexpr (!Epi::AFTER_DRAIN) { E(acc, cur, wr, wc, fr, fq); S.done(cur); }
        if (!has_next) break;
#pragma unroll
        for (int a = 0; a < 2; ++a)
#pragma unroll
            for (int b = 0; b < 2; ++b)
#pragma unroll
                for (int m = 0; m < 4; ++m)
#pragma unroll
                    for (int n = 0; n < 2; ++n) { float z_ = 0.f; asm volatile("" : "+v"(z_)); acc[a][b][m][n] = (f32x4){z_, z_, z_, z_}; }
        cur = nxt; cA = nA; cB = nB; ++ui;
        if constexpr (ALIGN_EPI) { if (wr == 1) PG8_BAR; }
    }
    PG8_WAIT_V(0);
    if constexpr (!ALIGN_EPI) { if (wr == 0) PG8_BAR; }
    PG8_BAR;
    if constexpr (Epi::AFTER_DRAIN) { E.fused(acc, cur, wr, wc, fr, fq, lds, wid, lane); S.done(cur); }
#undef PG8_SA
#undef PG8_SB
#undef PG8_STAGE
#undef PG8_LDA
#undef PG8_LDB
#undef PG8_MMA
#undef PG8_WAIT_V
#undef PG8_WAIT_L
#undef PG8_BAR
#undef PG8_SCHED
}
}
namespace pg8 {
#define PG8_GAS __attribute__((address_space(1)))
__device__ __forceinline__ float bf_lo(unsigned w) { return __uint_as_float(w << 16); }
__device__ __forceinline__ float bf_hi(unsigned w) { return __uint_as_float(w & 0xffff0000u); }
__device__ __forceinline__ float silu_mul(float g, float u) { return g * __builtin_amdgcn_rcpf(1.0f + __builtin_amdgcn_exp2f(-1.4426950408889634f * g)) * u; }
struct EpiSwiglu {
    static constexpr bool PERM = true, AFTER_DRAIN = false;
    bf16_t* O; const float* ss; int ldo;
    __device__ __forceinline__ void operator()(const f32x4 (&acc)[2][2][4][2], const Unit& u, int wr, int wc, int fr, int fq) const {
        const int row0 = u.pm * BM + wr * 64 + fr, col0 = u.pn * HALF + wc * 32 + 8 * fq;
#pragma unroll
        for (int ai = 0; ai < 2; ++ai)
#pragma unroll
            for (int m = 0; m < 4; ++m) { const int row = row0 + ai * HALF + m * 16; const float ri = __builtin_amdgcn_rsqf(((const PG8_GAS float*)ss)[row] * (1.0f / 2048.0f) + 1e-6f);
                const f32x4 g0 = acc[ai][0][m][0] * ri, g1 = acc[ai][0][m][1] * ri, u0 = acc[ai][1][m][0] * ri, u1 = acc[ai][1][m][1] * ri;
                u32x4 w; w.x = cvt_pk_bf16(silu_mul(g0[0], u0[0]), silu_mul(g0[1], u0[1])); w.y = cvt_pk_bf16(silu_mul(g0[2], u0[2]), silu_mul(g0[3], u0[3]));
                w.z = cvt_pk_bf16(silu_mul(g1[0], u1[0]), silu_mul(g1[1], u1[1])); w.w = cvt_pk_bf16(silu_mul(g1[2], u1[2]), silu_mul(g1[3], u1[3]));
                *(PG8_GAS u32x4*)(O + (size_t)row * ldo + col0) = w; }
    }
};
struct EpiScale {
    static constexpr bool PERM = true, AFTER_DRAIN = false;
    bf16_t* O; const float* ss; int ldo;
    __device__ __forceinline__ void operator()(const f32x4 (&acc)[2][2][4][2], const Unit& u, int wr, int wc, int fr, int fq) const {
        const int row0 = u.pm * BM + wr * 64 + fr, col0 = u.pn * BM + wc * 32 + 8 * fq;
#pragma unroll
        for (int ai = 0; ai < 2; ++ai)
#pragma unroll
            for (int m = 0; m < 4; ++m) { const int row = row0 + ai * HALF + m * 16; const float ri = __builtin_amdgcn_rsqf(((const PG8_GAS float*)ss)[row] * (1.0f / 2048.0f) + 1e-6f);
#pragma unroll
                for (int bj = 0; bj < 2; ++bj) { const f32x4 v0 = acc[ai][bj][m][0] * ri, v1 = acc[ai][bj][m][1] * ri;
                    u32x4 w; w.x = cvt_pk_bf16(v0[0], v0[1]); w.y = cvt_pk_bf16(v0[2], v0[3]); w.z = cvt_pk_bf16(v1[0], v1[1]); w.w = cvt_pk_bf16(v1[2], v1[3]);
                    *(PG8_GAS u32x4*)(O + (size_t)row * ldo + col0 + bj * HALF) = w; } }
    }
};
struct EpiResid {
    static constexpr bool PERM = true, AFTER_DRAIN = false;
    bf16_t* H; float* ssn; float alpha;
    __device__ __forceinline__ void operator()(const f32x4 (&acc)[2][2][4][2], const Unit& u, int wr, int wc, int fr, int fq) const {
        const int row0 = u.pm * BM + wr * 64 + fr, col0 = u.pn * BM + wc * 32 + 8 * fq;
#pragma unroll
        for (int ai = 0; ai < 2; ++ai)
#pragma unroll
            for (int m = 0; m < 4; ++m) { const int row = row0 + ai * HALF + m * 16; float sq = 0.f;
#pragma unroll
                for (int bj = 0; bj < 2; ++bj) { bf16_t* hp = H + (size_t)row * 2048 + col0 + bj * HALF; const u32x4 h = *(const PG8_GAS u32x4*)hp;
                    const f32x4 a0 = acc[ai][bj][m][0], a1 = acc[ai][bj][m][1];
                    const float n0 = bf_lo(h.x) + alpha * a0[0], n1 = bf_hi(h.x) + alpha * a0[1], n2 = bf_lo(h.y) + alpha * a0[2], n3 = bf_hi(h.y) + alpha * a0[3];
                    const float n4 = bf_lo(h.z) + alpha * a1[0], n5 = bf_hi(h.z) + alpha * a1[1], n6 = bf_lo(h.w) + alpha * a1[2], n7 = bf_hi(h.w) + alpha * a1[3];
                    sq += (n0 * n0 + n1 * n1) + (n2 * n2 + n3 * n3) + (n4 * n4 + n5 * n5) + (n6 * n6 + n7 * n7);
                    u32x4 w; w.x = cvt_pk_bf16(n0, n1); w.y = cvt_pk_bf16(n2, n3); w.z = cvt_pk_bf16(n4, n5); w.w = cvt_pk_bf16(n6, n7);
                    *(PG8_GAS u32x4*)hp = w; }
                sq += __int_as_float(__builtin_amdgcn_ds_swizzle(__float_as_int(sq), 0x401F)); { auto rr = __builtin_amdgcn_permlane32_swap(__float_as_uint(sq), __float_as_uint(sq), false, false); sq = __uint_as_float(rr[0]) + __uint_as_float(rr[1]); }
                if (fq == 0) atomicAdd(ssn + row, sq); }
    }
};
struct EpiSlab {
    static constexpr bool PERM = true, AFTER_DRAIN = false;
    float* slab; int trows;
    __device__ __forceinline__ void operator()(const f32x4 (&acc)[2][2][4][2], const Unit& u, int wr, int wc, int fr, int fq) const {
        const int col0 = u.pn * BM + wc * 32 + 8 * fq;
#pragma unroll
        for (int m = 0; m < 4; ++m) { const int row = wr * 64 + m * 16 + fr;
            if (row < trows) { float* p = slab + ((size_t)u.pm * trows + row) * 2048 + col0;
#pragma unroll
                for (int bj = 0; bj < 2; ++bj) { *(PG8_GAS f32x4*)(p + bj * HALF) = acc[0][bj][m][0]; *(PG8_GAS f32x4*)(p + bj * HALF + 4) = acc[0][bj][m][1]; } } }
    }
};
}
namespace att {
typedef unsigned short bf16_t;
using bf16x8 = __attribute__((ext_vector_type(8))) short;
using s16x4  = __attribute__((ext_vector_type(4))) short;
using f32x16 = __attribute__((ext_vector_type(16))) float;
using u32x4  = __attribute__((ext_vector_type(4))) unsigned;
constexpr int NW = 8, QBLK = 32, KVBLK = 64, LD = 4608;
constexpr int SHM_V = KVBLK * 128 * 2, SHM_K = KVBLK * 128 * 2;
constexpr int OFF_V = 0, OFF_K = 2 * SHM_V, OFF_WS = OFF_K + 2 * SHM_K, OFF_LUT = OFF_WS + NW * 64 * 4, OFF_O1 = OFF_LUT + 2048, OFF_MISC = OFF_O1 + 65536, ATT_LDS = OFF_MISC + 1024;
constexpr int LUTN = 449, LUTC = 224;
constexpr float THR2 = 11.5f;
#define KSWZ(row, colB) ((row) * 256 + ((colB) ^ (((row) & 15) << 4)))
#define KSWZ64(row, colB) ((row) * 128 + ((colB) ^ ((((row) >> 1) & 7) << 4)))
#define SBAR() __builtin_amdgcn_sched_barrier(0)
#define GLD8(p) (*(const __attribute__((address_space(1))) bf16x8*)(p))
__device__ __forceinline__ int crow(int r, int hi) { return (r & 3) + 8 * (r >> 2) + 4 * hi; }
__device__ __forceinline__ unsigned cvtpk(float lo, float hi) { unsigned r; asm volatile("v_cvt_pk_bf16_f32 %0, %1, %2" : "=v"(r) : "v"(lo), "v"(hi)); return r; }

template <bool FIRST> __device__ __forceinline__ void partialSM(f32x16& p0, f32x16& p1, float& m_reg, float& alpha, f32x16& negm, float c_cur) {
  float pmax = p0[0];
#pragma unroll
  for (int r = 1; r < 16; ++r) pmax = fmaxf(pmax, p0[r]);
#pragma unroll
  for (int r = 0; r < 16; ++r) pmax = fmaxf(pmax, p1[r]);
  { auto rr = __builtin_amdgcn_permlane32_swap(__float_as_uint(pmax), __float_as_uint(pmax), false, false);
    pmax = fmaxf(__uint_as_float(rr[0]), __uint_as_float(rr[1])); }
  alpha = 1.f;
  if (FIRST || !__builtin_expect(__all(pmax <= THR2), 1)) {
    const float d = FIRST ? pmax : fmaxf(pmax, 0.f); m_reg += d; if (!FIRST) alpha = __builtin_amdgcn_exp2f(-d);
#pragma unroll
    for (int r = 0; r < 16; ++r) { p0[r] -= d; p1[r] -= d; }
    const float nm = c_cur - m_reg;
#pragma unroll
    for (int r = 0; r < 16; ++r) negm[r] = nm;
  }
#pragma unroll
  for (int r = 0; r < 16; ++r) p0[r] = __builtin_amdgcn_exp2f(p0[r]);
}
__device__ __forceinline__ void finishSM(f32x16& p0, f32x16& p1, float alpha, float& l_reg, bf16x8& pa0, bf16x8& pa1, bf16x8& pa2, bf16x8& pa3) {
#pragma unroll
  for (int r = 0; r < 16; ++r) p1[r] = __builtin_amdgcn_exp2f(p1[r]);
  float ps = 0;
#pragma unroll
  for (int r = 0; r < 16; ++r) ps += p0[r];
#pragma unroll
  for (int r = 0; r < 16; ++r) ps += p1[r];
  { auto rr = __builtin_amdgcn_permlane32_swap(__float_as_uint(ps), __float_as_uint(ps), false, false);
    ps = __uint_as_float(rr[0]) + __uint_as_float(rr[1]); }
  l_reg = l_reg * alpha + ps;
#define PK4(P, BASE, OUT) do { unsigned a0 = cvtpk(P[BASE + 0], P[BASE + 1]), a1 = cvtpk(P[BASE + 2], P[BASE + 3]);   \
    unsigned b0 = cvtpk(P[BASE + 4], P[BASE + 5]), b1 = cvtpk(P[BASE + 6], P[BASE + 7]);                              \
    auto r0 = __builtin_amdgcn_permlane32_swap(a0, b0, false, false); auto r1 = __builtin_amdgcn_permlane32_swap(a1, b1, false, false); \
    u32x4 w = {r0[0], r1[0], r0[1], r1[1]}; OUT = *reinterpret_cast<bf16x8*>(&w); } while (0)
  PK4(p0, 0, pa0); PK4(p0, 8, pa1); PK4(p1, 0, pa2); PK4(p1, 8, pa3);
#undef PK4
}
template <int DQK> __device__ __forceinline__ void qkt(f32x16& p0, f32x16& p1, const char* Ks, const bf16x8* qr, int r32, int hi, const f32x16& negm) {
#pragma unroll
  for (int d0 = 0; d0 < DQK / 16; ++d0) { const int cb = (d0 * 16 + hi * 8) * 2;
    const bf16x8 b0 = *reinterpret_cast<const bf16x8*>(Ks + (DQK == 128 ? KSWZ(r32, cb) : KSWZ64(r32, cb)));
    const bf16x8 b1 = *reinterpret_cast<const bf16x8*>(Ks + (DQK == 128 ? KSWZ(32 + r32, cb) : KSWZ64(32 + r32, cb)));
    if (d0 == 0) { p0 = __builtin_amdgcn_mfma_f32_32x32x16_bf16(b0, qr[0], negm, 0, 0, 0); p1 = __builtin_amdgcn_mfma_f32_32x32x16_bf16(b1, qr[0], negm, 0, 0, 0); }
    else { p0 = __builtin_amdgcn_mfma_f32_32x32x16_bf16(b0, qr[d0], p0, 0, 0, 0); p1 = __builtin_amdgcn_mfma_f32_32x32x16_bf16(b1, qr[d0], p1, 0, 0, 0); } }
}
__device__ __forceinline__ int v_st(int k, int c) { const int kk = (k & ~0xC) | ((k & 4) << 1) | ((k & 8) >> 1); return ((kk >> 3) * 4 + (c >> 5)) * 512 + ((kk & 7) * 32 + (c & 31)) * 2; }
__device__ __forceinline__ int v_rd_base(int lane) { return ((lane & 3) << 3) | (((lane >> 2) & 3) << 6) | (((lane >> 4) & 1) << 5) | (((lane >> 5) & 1) << 8); }
constexpr int v_rd_off(int d0, int ks, int half) { return d0 * 512 + ks * 4096 + half * 2048; }
template <int OFF> __device__ __forceinline__ s16x4 tr_read(int vb) {
  s16x4 r; asm volatile("ds_read_b64_tr_b16 %0, %1 offset:%2" : "=&v"(r) : "v"(vb), "i"(OFF) : "memory"); return r;
}
template <int D0> __device__ __forceinline__ void pv_one(f32x16& od, int vb, bf16x8 pa0, bf16x8 pa1, bf16x8 pa2, bf16x8 pa3) {
  const s16x4 l0 = tr_read<v_rd_off(D0, 0, 0)>(vb), h0 = tr_read<v_rd_off(D0, 0, 1)>(vb), l1 = tr_read<v_rd_off(D0, 1, 0)>(vb), h1 = tr_read<v_rd_off(D0, 1, 1)>(vb);
  const s16x4 l2 = tr_read<v_rd_off(D0, 2, 0)>(vb), h2 = tr_read<v_rd_off(D0, 2, 1)>(vb), l3 = tr_read<v_rd_off(D0, 3, 0)>(vb), h3 = tr_read<v_rd_off(D0, 3, 1)>(vb);
  asm volatile("s_waitcnt lgkmcnt(0)" ::: "memory"); SBAR();
#define PK(L, H) (bf16x8){L[0], L[1], L[2], L[3], H[0], H[1], H[2], H[3]}
  od = __builtin_amdgcn_mfma_f32_32x32x16_bf16(pa0, PK(l0, h0), od, 0, 0, 0);
  od = __builtin_amdgcn_mfma_f32_32x32x16_bf16(pa1, PK(l1, h1), od, 0, 0, 0);
  od = __builtin_amdgcn_mfma_f32_32x32x16_bf16(pa2, PK(l2, h2), od, 0, 0, 0);
  od = __builtin_amdgcn_mfma_f32_32x32x16_bf16(pa3, PK(l3, h3), od, 0, 0, 0);
#undef PK
}
__device__ __forceinline__ void pv_d0(f32x16* o, int vb, bf16x8 pa0, bf16x8 pa1, bf16x8 pa2, bf16x8 pa3) {
  pv_one<0>(o[0], vb, pa0, pa1, pa2, pa3); pv_one<1>(o[1], vb, pa0, pa1, pa2, pa3); pv_one<2>(o[2], vb, pa0, pa1, pa2, pa3); pv_one<3>(o[3], vb, pa0, pa1, pa2, pa3);
}
template <bool BIAS, bool VIRT> __device__ __forceinline__ void fixup(f32x16& p0, f32x16& p1, int t, int L, int qw0, int r32, int hi, const float* lut) {
  const int k0 = KVBLK * t;
  if (BIAS) {
    const int lo = k0 - (qw0 + (VIRT ? 15 : 31)), hi_ = k0 + 63 - qw0;
    if (!(lo >= 128 || hi_ <= -128)) {
      const float* lb = lut + (k0 - (qw0 + (VIRT ? (r32 & 15) : r32)) + LUTC + 4 * hi);
#pragma unroll
      for (int r = 0; r < 16; ++r) { const int kv = (r & 3) + 8 * (r >> 2); p0[r] += lb[kv]; p1[r] += lb[kv + 32]; }
    }
  }
  if (__builtin_expect(k0 + KVBLK > L, 0)) {
    asm volatile("" ::: "memory");
    const int kb = k0 + 4 * hi;
#pragma unroll
    for (int r = 0; r < 16; ++r) { const int kv = kb + (r & 3) + 8 * (r >> 2); if (kv >= L) p0[r] = -INFINITY; if (kv + 32 >= L) p1[r] = -INFINITY; }
  }
}
template <bool BIAS, bool VIRT> __device__ __forceinline__ float cinit(int t, int qw0, const float* lut) {
  if (!BIAS) return 0.f;
  const int k0 = KVBLK * t, lo = k0 - (qw0 + (VIRT ? 15 : 31)), hi_ = k0 + 63 - qw0;
  return lo >= 128 ? lut[LUTN - 1] : (hi_ <= -128 ? lut[0] : 0.f);
}
template <int DQK, bool BIAS, bool VIRT = false>
__device__ __forceinline__ void attn_pass(const bf16_t* __restrict__ Qb, const bf16_t* __restrict__ Kh, const bf16_t* __restrict__ Vh, int L, int NT, int qw0, const float* lut, f32x16 (&o)[4], char* lds, int nact) {
  const int tid = ltid(), wid = __builtin_amdgcn_readfirstlane(tid >> 6), lane = tid & 63, r32 = lane & 31, hi = lane >> 5;
  char* V_lds = lds + OFF_V; char* K_lds = lds + OFF_K;
  float* ws = (float*)(lds + OFF_WS) + wid * 64; float* li_l = ws; float* al_l = ws + 32;
  float m_reg = 0.f, l_reg = 0, c_cur = cinit<BIAS, VIRT>(0, qw0, lut);
  f32x16 negm;
#pragma unroll
  for (int r = 0; r < 16; ++r) negm[r] = c_cur;
#pragma unroll
  for (int d = 0; d < 4; ++d)
#pragma unroll
    for (int r = 0; r < 16; ++r) o[d][r] = 0.f;
  bf16x8 qr[DQK / 16];
  if (VIRT) {
    const int mp = r32 >> 4; const bf16_t* Qw = Qb + (long)(wid * 16 + (r32 & 15)) * LD + mp * 64 + hi * 8;
    short zs = 0; asm volatile("" : "+v"(zs)); const bf16x8 z = {zs, zs, zs, zs, zs, zs, zs, zs};
#pragma unroll
    for (int j = 0; j < 4; ++j) { const bf16x8 v = GLD8(Qw + j * 16); qr[j] = mp == 0 ? v : z; qr[(j + 4) % (DQK / 16)] = mp == 0 ? z : v; }
  } else {
    const bf16_t* Qw = Qb + (long)(wid * QBLK + r32) * LD + hi * 8;
#pragma unroll
    for (int d0 = 0; d0 < DQK / 16; ++d0) qr[d0] = __builtin_nontemporal_load((const __attribute__((address_space(1))) bf16x8*)(Qw + d0 * 16));
  }
  const int sr = tid >> 4, sc = (tid & 15) * 8, vst0 = v_st(sr, sc), vst1 = v_st(32 + sr, sc);
  const int kr = tid >> 3, kc = (tid & 7) * 8;
  const int vb0 = (int)(uintptr_t)V_lds + v_rd_base(lane);
  constexpr int SDEPTH = DQK == 128 ? 1 : 2;
  struct { bf16x8 vs0, vs1, ks0, ks1; } sr_[SDEPTH];
#define SLOAD(i, k0) do { sr_[i].vs0 = GLD8(&Vh[(long)((k0) + sr) * LD + sc]); sr_[i].vs1 = GLD8(&Vh[(long)((k0) + 32 + sr) * LD + sc]); \
    if (DQK == 128) { sr_[i].ks0 = GLD8(&Kh[(long)((k0) + sr) * LD + sc]); sr_[i].ks1 = GLD8(&Kh[(long)((k0) + 32 + sr) * LD + sc]); } \
    else { sr_[i].ks0 = GLD8(&Kh[(long)((k0) + kr) * LD + kc]); } } while (0)
#define SWRITE(b, i) do { *(bf16x8*)(V_lds + (b) * SHM_V + vst0) = sr_[i].vs0; *(bf16x8*)(V_lds + (b) * SHM_V + vst1) = sr_[i].vs1; \
    if (DQK == 128) { *(bf16x8*)(K_lds + (b) * SHM_K + KSWZ(sr, sc * 2)) = sr_[i].ks0; *(bf16x8*)(K_lds + (b) * SHM_K + KSWZ(32 + sr, sc * 2)) = sr_[i].ks1; } \
    else { *(bf16x8*)(K_lds + (b) * SHM_K + KSWZ64(kr, kc * 2)) = sr_[i].ks0; } } while (0)
#define SWAIT() do { if (SDEPTH == 1) asm volatile("s_waitcnt vmcnt(0)" ::: "memory"); else if (DQK == 128) asm volatile("s_waitcnt vmcnt(4)" ::: "memory"); else asm volatile("s_waitcnt vmcnt(3)" ::: "memory"); } while (0)
#define RESC(a) do { if (__any((a) < 1.f)) { if (hi == 0) al_l[r32] = (a); asm volatile("s_waitcnt lgkmcnt(0)" ::: "memory"); \
    _Pragma("unroll") for (int d = 0; d < 4; ++d) _Pragma("unroll") for (int r = 0; r < 16; ++r) o[d][r] *= al_l[crow(r, hi)]; } } while (0)
  f32x16 pA0, pA1, pB0, pB1; float alA, alB; bf16x8 pa0, pa1, pa2, pa3;
  constexpr int SE = 0, SO = SDEPTH - 1;
  if (wid >= nact) {
    SLOAD(SE, 0); asm volatile("s_waitcnt vmcnt(0)" ::: "memory"); SWRITE(0, SE); __syncthreads();
    SLOAD(SO, KVBLK); if (SDEPTH == 2) { if (2 < NT) SLOAD(SE, 2 * KVBLK); }
    SWAIT(); SWRITE(1, SO); __syncthreads();
    for (int j = 1; j + 1 < NT; j += 2) {
      SLOAD(SO, (j + SDEPTH) * KVBLK); __syncthreads(); SWAIT(); SWRITE(0, SE); __syncthreads();
      if (SDEPTH == 1 || j + 3 < NT) SLOAD(SE, (j + 1 + SDEPTH) * KVBLK);
      __syncthreads(); SWAIT(); SWRITE(1, SO); __syncthreads();
    }
    __syncthreads();
    return;
  }
#define NEGM(t) do { if (BIAS) { const float c_ = cinit<BIAS, VIRT>((t), qw0, lut); if (c_ != c_cur) { c_cur = c_; const float nm_ = c_ - m_reg; _Pragma("unroll") for (int r = 0; r < 16; ++r) negm[r] = nm_; } } } while (0)
  SLOAD(SE, 0); asm volatile("s_waitcnt vmcnt(0)" ::: "memory"); SWRITE(0, SE); __syncthreads();
  qkt<DQK>(pA0, pA1, K_lds, qr, r32, hi, negm); fixup<BIAS, VIRT>(pA0, pA1, 0, L, qw0, r32, hi, lut); partialSM<true>(pA0, pA1, m_reg, alA, negm, c_cur);
  SLOAD(SO, KVBLK); if (SDEPTH == 2) { if (2 < NT) SLOAD(SE, 2 * KVBLK); }
  SWAIT(); SWRITE(1, SO); __syncthreads();
  for (int j = 1; j + 1 < NT; j += 2) {
    NEGM(j); SBAR(); qkt<DQK>(pB0, pB1, K_lds + SHM_K, qr, r32, hi, negm);
    finishSM(pA0, pA1, alA, l_reg, pa0, pa1, pa2, pa3); SBAR();
    SLOAD(SO, (j + SDEPTH) * KVBLK); SBAR();
    pv_d0(o, vb0, pa0, pa1, pa2, pa3); fixup<BIAS, VIRT>(pB0, pB1, j, L, qw0, r32, hi, lut); partialSM<false>(pB0, pB1, m_reg, alB, negm, c_cur);
    __syncthreads(); SWAIT(); SWRITE(0, SE);
    RESC(alB); __syncthreads();
    NEGM(j + 1); SBAR(); qkt<DQK>(pA0, pA1, K_lds, qr, r32, hi, negm);
    finishSM(pB0, pB1, alB, l_reg, pa0, pa1, pa2, pa3); SBAR();
    if (SDEPTH == 1 || j + 3 < NT) SLOAD(SE, (j + 1 + SDEPTH) * KVBLK); SBAR();
    pv_d0(o, vb0 + SHM_V, pa0, pa1, pa2, pa3); fixup<BIAS, VIRT>(pA0, pA1, j + 1, L, qw0, r32, hi, lut); partialSM<false>(pA0, pA1, m_reg, alA, negm, c_cur);
    __syncthreads(); SWAIT(); SWRITE(1, SO);
    RESC(alA); __syncthreads();
  }
  NEGM(NT - 1); SBAR(); qkt<DQK>(pB0, pB1, K_lds + SHM_K, qr, r32, hi, negm);
  finishSM(pA0, pA1, alA, l_reg, pa0, pa1, pa2, pa3); SBAR();
  pv_d0(o, vb0, pa0, pa1, pa2, pa3); fixup<BIAS, VIRT>(pB0, pB1, NT - 1, L, qw0, r32, hi, lut); partialSM<false>(pB0, pB1, m_reg, alB, negm, c_cur);
  __syncthreads(); RESC(alB);
  finishSM(pB0, pB1, alB, l_reg, pa0, pa1, pa2, pa3); SBAR();
  pv_d0(o, vb0 + SHM_V, pa0, pa1, pa2, pa3);
  if (hi == 0) li_l[r32] = l_reg; asm volatile("s_waitcnt lgkmcnt(0)" ::: "memory");
#pragma unroll
  for (int r = 0; r < 16; ++r) { const float rl = __builtin_amdgcn_rcpf(li_l[crow(r, hi)]);
#pragma unroll
    for (int d = 0; d < 4; ++d) o[d][r] *= rl; }
#undef SLOAD
#undef SWRITE
#undef SWAIT
#undef NEGM
#undef RESC
}
}
#define GAS __attribute__((address_space(1)))
#define XB_TMO      128
#define XB_XCNT(j)  (256  + 64 * (j))
#define XB_XSUB(j)  (1280 + 64 * (j))
#define XB_XGEN(j)  (2304 + 64 * (j))
#define XB_TOP      3328
#define XB_TOPGEN   3392
#define XCD_BAR_WORDS 3456
#define XB_SPIN_CAP (1u << 18)

__device__ __forceinline__ unsigned xb_ld(unsigned* p)              { return __hip_atomic_load(p, __ATOMIC_RELAXED, __HIP_MEMORY_SCOPE_AGENT); }
__device__ __forceinline__ unsigned xb_add(unsigned* p, unsigned v) { return __hip_atomic_fetch_add(p, v, __ATOMIC_RELAXED, __HIP_MEMORY_SCOPE_AGENT); }
__device__ __forceinline__ unsigned xb_xcc_id() { return (unsigned)__builtin_amdgcn_s_getreg((3 << 11) | 20) & 0xFu; }
#define XB_SPIN(cond, bar) do { unsigned _sp = 0; while (cond) { __builtin_amdgcn_s_sleep(1); \
    if ((++_sp & 255u) == 0u) { if (xb_ld(&(bar)[XB_TMO])) break; if (_sp > XB_SPIN_CAP) { atomicAdd(&(bar)[XB_TMO], 1u); break; } } } } while (0)

struct XcdBarrier {
    unsigned* bar; unsigned x;
    volatile LAS unsigned* st;
};

__device__ __forceinline__ XcdBarrier xcd_barrier_post(unsigned* bar, volatile LAS unsigned* st) {
    XcdBarrier b; b.bar = bar; b.x = xb_xcc_id(); b.st = st;
    if (threadIdx.x == 0) (void)xb_add(&bar[XB_XCNT(b.x)], 1u);
    return b;
}
__device__ __forceinline__ void xcd_barrier_complete(unsigned* bar, unsigned x, unsigned& nloc, unsigned& nx) {
    const unsigned G = gridDim.x * gridDim.y * gridDim.z;
    unsigned sum, cnt, mine, sp = 0u;
    for (;;) {
        sum = 0u; cnt = 0u; mine = 0u;
#pragma unroll
        for (unsigned j = 0; j < 16; ++j) { const unsigned c = xb_ld(&bar[XB_XCNT(j)]); sum += c; cnt += (c > 0u) ? 1u : 0u; mine = (j == x) ? c : mine; }
        if (sum == G) break;
        __builtin_amdgcn_s_sleep(1);
        if ((++sp & 255u) == 0u) { if (xb_ld(&bar[XB_TMO])) break; if (sp > XB_SPIN_CAP) { atomicAdd(&bar[XB_TMO], 1u); break; } }
    }
    nloc = mine > 0u ? mine : 1u; nx = cnt > 0u ? cnt : 1u;
}

__device__ __forceinline__ void xcd_barrier(const XcdBarrier& b) {
    asm volatile("s_waitcnt vmcnt(0)" ::: "memory");
    __syncthreads();
    if (threadIdx.x == 0) {
        unsigned* bar = b.bar; asm volatile("" : "+s"(bar));
        __builtin_amdgcn_s_waitcnt(0);
        unsigned nloc = b.st[0], nx = b.st[1];
        if (nloc == 0u) { xcd_barrier_complete(bar, b.x, nloc, nx); b.st[0] = nloc; b.st[1] = nx; }
        const unsigned old = xb_add(&bar[XB_XSUB(b.x)], 1u);
        const unsigned gen = old / nloc;
        if (old + 1u == (gen + 1u) * nloc) {
            __builtin_amdgcn_fence(__ATOMIC_RELEASE, "agent");
            asm volatile("s_waitcnt vmcnt(0)" ::: "memory");
            const unsigned og = xb_add(&bar[XB_TOP], 1u);
            const unsigned tg = og / nx;
            if (og + 1u == (tg + 1u) * nx) xb_add(&bar[XB_TOPGEN], 1u);
            else XB_SPIN(xb_ld(&bar[XB_TOPGEN]) == tg, bar);
            __builtin_amdgcn_fence(__ATOMIC_ACQUIRE, "agent");
            xb_add(&bar[XB_XGEN(b.x)], 1u);
            asm volatile("s_waitcnt vmcnt(0)" ::: "memory");
        } else {
            XB_SPIN(xb_ld(&bar[XB_XGEN(b.x)]) == gen, bar);
            __builtin_amdgcn_fence(__ATOMIC_ACQUIRE, "agent");
            asm volatile("s_waitcnt vmcnt(0)" ::: "memory");
        }
    }
    __syncthreads();
}

typedef unsigned short bf16_t;
typedef unsigned v4u __attribute__((ext_vector_type(4)));
typedef float f32x4 __attribute__((ext_vector_type(4)));
constexpr int NWAVES = 8;
constexpr int DM = 2048, DFF = 5632, NIN = 4608, NMETA = 16;
constexpr int LP = 2064, LS = 16400, NTP = 34, NTS = 258;
constexpr int MREAL = 4 * LP + LS, MPAD = 24832, NOUT = 4 * 2048 + 16384, MFULL = 96 * 256, TROWS = MREAL - MFULL  , KSPLIT = 256;
constexpr float EPS = 1e-6f, LOG2E = 1.4426950408889634f;
constexpr float QSCALE_A = 0.125f * LOG2E, QSCALE_B = 0.08838834764831845f * LOG2E;
constexpr size_t MiB = 1u << 20;
constexpr size_t WS_CTL = 0, WS_SS = 1 * MiB, WS_W1IN = 2 * MiB, WS_W1OUT = 46 * MiB, WS_WIN = 68 * MiB, WS_WOUT = 86 * MiB, WS_W2IN = 94 * MiB, WS_W2OUT = 138 * MiB,
                 WS_HB = 160 * MiB, WS_ACT = 257 * MiB, WS_SLAB = 524 * MiB  , WS_END = WS_SLAB + (size_t)(DFF / KSPLIT) * TROWS * DM * 4;
static_assert(WS_ACT + (size_t)MPAD * DFF * 2 <= WS_SLAB, "ws map 2");
static_assert(WS_HB + (size_t)MPAD * DM * 2 <= WS_ACT && 4 * MPAD * 4 <= (int)MiB, "ws map");
constexpr int CW_CNT = 0  , CW_LAM = 1024, CW_LUT = 2048  , CW_BAR = 8192  ;
constexpr size_t CTL_ZERO_BYTES = 65536;
constexpr int QUNITS = 64 + 64 + 2 + 32 + 4 + 36;
constexpr int I_FI = (DM / 64) * (2 * DFF / 64), I_FO = (DFF / 64) * (DM / 64), I_MI = (DM / 64) * (NIN / 64), I_MO = (DM / 64) * (DM / 64);
constexpr int NDEF = I_FI + I_FO + I_MO, NTRU = (NDEF + 63) / 64, CW_TRC = 1536;
constexpr int LDS_BYTES = att::ATT_LDS > pg8::STAGE_BYTES ? att::ATT_LDS : pg8::STAGE_BYTES;
static_assert(8 * 16640 <= LDS_BYTES, "P0 transpose tiles");

#ifndef MK_PHMASK
#define MK_PHMASK 0x3ff
#endif
#define PHON(k) (((MK_PHMASK) >> (k)) & 1)
#ifndef MK_SEQ
#define MK_SEQ 0x9876543210ull
#define MK_NSEQ 10
#endif
#define SWZ(v, pat) __int_as_float(__builtin_amdgcn_ds_swizzle(__float_as_int(v), (pat)))
struct Args { const float* in[17]; float* out; unsigned char* ws; int ph_lo, ph_hi; };

__device__ __forceinline__ unsigned f2bf(float f) { unsigned u = __builtin_bit_cast(unsigned, f); return (u + 0x7fffu + ((u >> 16) & 1u)) >> 16; }
__device__ __forceinline__ unsigned pk2(float lo, float hi) { return f2bf(lo) | (f2bf(hi) << 16); }
__device__ __forceinline__ float wave_sum(float v) {
#define WS_SWZ(x, pat) __int_as_float(__builtin_amdgcn_ds_swizzle(__float_as_int(x), (pat)))
    v += WS_SWZ(v, 0x041F); v += WS_SWZ(v, 0x081F); v += WS_SWZ(v, 0x101F); v += WS_SWZ(v, 0x201F); v += WS_SWZ(v, 0x401F);
#undef WS_SWZ
    auto rr = __builtin_amdgcn_permlane32_swap(__float_as_uint(v), __float_as_uint(v), false, false);
    return __uint_as_float(rr[0]) + __uint_as_float(rr[1]);
}
__device__ __forceinline__ void tr_item(const float* __restrict__ W, int K, int N, bf16_t* __restrict__ WT, const float* __restrict__ gain, int mode, LAS float* scr, int item, int lane) {
    const int nblk = N / 64, kb = item / nblk, nb = item % nblk, k0 = 64 * kb, n0 = 64 * nb;
    int src0 = n0; float cs = 1.f;
    if (mode == 1) { const int pn = n0 >> 8, w = n0 & 255; src0 = (w >> 7) * DFF + pn * 128 + (w & 127); }
    if (mode == 2 && n0 < 1024) cs = QSCALE_A;
    const int lk = lane >> 4, ln = (lane & 15) * 4;
#pragma unroll 8
    for (int i = 0; i < 16; ++i) { const int kk = 4 * i + lk; const float g = gain ? gain[k0 + kk] * cs : cs; const f32x4 v = __builtin_nontemporal_load((const f32x4*)(W + (size_t)(k0 + kk) * N + src0 + ln));
        LAS float* d = scr + kk * 65 + ln; d[0] = v.x * g; d[1] = v.y * g; d[2] = v.z * g; d[3] = v.w * g; }
    asm volatile("s_waitcnt lgkmcnt(0)" ::: "memory");
    const int c = lane >> 3, nn = lane & 7;
#pragma unroll
    for (int j = 0; j < 8; ++j) { const int n = nn + 8 * j; const LAS float* s = scr + (8 * c) * 65 + n;
        v4u o; o.x = pk2(s[0 * 65], s[1 * 65]); o.y = pk2(s[2 * 65], s[3 * 65]); o.z = pk2(s[4 * 65], s[5 * 65]); o.w = pk2(s[6 * 65], s[7 * 65]);
        *(v4u*)(WT + (size_t)(n0 + n) * K + k0 + 8 * c) = o; }
    asm volatile("s_waitcnt lgkmcnt(0)" ::: "memory");
}
__device__ __forceinline__ int t5_bucket(int rel) {
    const int n = rel < 0 ? -rel : rel; const int so = rel > 0 ? 16 : 0;
    int b; if (n < 8) b = n; else if (n < 12) b = 8; else if (n < 16) b = 9; else if (n < 23) b = 10; else if (n < 32) b = 11; else if (n < 46) b = 12; else if (n < 64) b = 13; else if (n < 91) b = 14; else b = 15;
    return so + b;
}

typedef const __attribute__((address_space(4))) Args* KArgP;
__device__ __forceinline__ KArgP kargs() { KArgP p = (KArgP)__builtin_amdgcn_kernarg_segment_ptr(); asm volatile("" : "+s"(p)); return p; }
__global__ void __launch_bounds__(NWAVES * 64) fwd_kernel(Args args) {
    extern __shared__ __attribute__((aligned(16))) unsigned char lds[];
    cg::grid_group grid = cg::this_grid();
    { volatile LAS unsigned* m0 = (volatile LAS unsigned*)((LAS unsigned char*)lds + att::OFF_MISC); if (threadIdx.x < 16) m0[threadIdx.x] = 0u; }
    __syncthreads();
    XcdBarrier bar = xcd_barrier_post((unsigned*)(kargs()->ws + WS_CTL) + CW_BAR, (volatile LAS unsigned*)((LAS unsigned char*)lds + att::OFF_MISC) + 8);
    for (int pi = args.ph_lo; pi < args.ph_hi; ++pi) {
        const int ph = (int)((MK_SEQ >> (4 * pi)) & 0xFull);
#define TIDS const int tid = ltid(), lane = tid & 63, wave = __builtin_amdgcn_readfirstlane(tid >> 6), gw = blockIdx.x * NWAVES + wave; (void)tid; (void)lane; (void)gw
        int G = gridDim.x; asm volatile("" : "+s"(G)); const int NGW = G * NWAVES;
        unsigned char* ws = kargs()->ws; asm volatile("" : "+s"(ws));
        unsigned* ctl = (unsigned*)(ws + WS_CTL);
        float* ssb = (float*)(ws + WS_SS);
        bf16_t* HB = (bf16_t*)(ws + WS_HB); bf16_t* ACT = (bf16_t*)(ws + WS_ACT); bf16_t* QKV = ACT; bf16_t* Y = (bf16_t*)kargs()->out;
#define WPTR(off) ((bf16_t*)(ws + (off)))
        if (ph == 0 && PHON(0)) { TIDS;
            LAS float* scr = (LAS float*)((LAS unsigned char*)lds + wave * 16640);
            const float* x_prompt = kargs()->in[0]; const float* x_sample = kargs()->in[1]; const float* meta = kargs()->in[2]; const float* rel_tab = kargs()->in[3];
            constexpr int NITEMS = I_FI + I_FO + I_MI;
            for (int it = gw; it < NITEMS; it += NGW) {
                int r = it;
                if (r < I_FI) { tr_item(kargs()->in[5], DM, 2 * DFF, WPTR(WS_W1IN), kargs()->in[4], 1, scr, r, lane); continue; } r -= I_FI;
                if (r < I_FO) { tr_item(kargs()->in[6], DFF, DM, WPTR(WS_W1OUT), nullptr, 0, scr, r, lane); continue; } r -= I_FO;
                tr_item(kargs()->in[8], DM, NIN, WPTR(WS_WIN), kargs()->in[7], 2, scr, r, lane);
            }
            for (int r = gw; r < MPAD; r += NGW) {
                unsigned long long* o8 = (unsigned long long*)(HB + (size_t)r * DM) + lane; float s2 = 0.f;
                if (r < MREAL) {
                    const int s = r < 4 * LP ? r / LP : 4, t = r < 4 * LP ? r % LP : r - 4 * LP;
                    const float* src = t < NMETA ? meta + (size_t)t * DM : (s < 4 ? x_prompt + ((size_t)s * 2048 + (t - NMETA)) * DM : x_sample + (size_t)(t - NMETA) * DM);
                    const f32x4* xr = (const f32x4*)src + lane;
#pragma unroll
                    for (int j = 0; j < 8; ++j) { const f32x4 v = __builtin_nontemporal_load(xr + 64 * j); s2 += (v.x * v.x + v.y * v.y) + (v.z * v.z + v.w * v.w);
                        o8[64 * j] = (unsigned long long)pk2(v.x, v.y) | ((unsigned long long)pk2(v.z, v.w) << 32); }
                    s2 = wave_sum(s2);
                } else {
#pragma unroll
                    for (int j = 0; j < 8; ++j) o8[64 * j] = 0ull;
                }
                if (lane == 0) ssb[r] = s2;
            }
            for (int i = blockIdx.x * 512 + tid; i < 3 * MPAD; i += G * 512) ssb[MPAD + i] = 0.f;
            for (int i = blockIdx.x * 512 + tid; i < (MPAD - MREAL) * (DM / 8); i += G * 512) { unsigned zz = 0u; asm volatile("" : "+v"(zz)); ((v4u*)(Y + (size_t)MREAL * DM))[i] = (v4u){zz, zz, zz, zz}; }
            if (blockIdx.x == 0) {
                if (tid < 16) ctl[CW_CNT + 64 * tid] = 0u;
                if (wave == 1) { const float* lp = kargs()->in[9]; const float a = wave_sum(lp[lane] * lp[64 + lane]), b = wave_sum(lp[128 + lane] * lp[192 + lane]);
                    if (lane == 0) ((float*)ctl)[CW_LAM] = expf(a) - expf(b) + 0.2f; }
                for (int i = tid; i < 8 * att::LUTN; i += 512) { const int h = i / att::LUTN, rel = i % att::LUTN - att::LUTC; ((float*)ctl)[CW_LUT + i] = rel_tab[t5_bucket(rel) * 8 + h] * LOG2E; }
            }
        } else if ((ph == 1 || ph == 7) && PHON(1)) {
            pg8::Gemm g{HB, ph == 1 ? WPTR(WS_W1IN) : WPTR(WS_W2IN), MPAD, 2 * DFF, DM, DM}; pg8::StaticOrder S; S.init(MPAD, 2 * DFF, G, (int)blockIdx.x);
            pg8::EpiSwiglu E{ACT, ssb + (ph == 1 ? 0 : 2) * MPAD, DFF};
            pg8::gemm_phase<pg8::EpiSwiglu, pg8::StaticOrder, true, true>((LAS unsigned char*)lds, g, S, E);
        } else if ((ph == 2 || ph == 6 || ph == 8) && PHON(2)) {
            const bf16_t* A = ph == 6 ? Y : ACT; const bf16_t* B = ph == 2 ? WPTR(WS_W1OUT) : (ph == 6 ? WPTR(WS_WOUT) : WPTR(WS_W2OUT)); const int K = ph == 6 ? DM : DFF;
            float* ssn = ssb + (ph == 2 ? 1 : (ph == 6 ? 2 : 3)) * MPAD; const float alpha = ph == 6 ? 1.0f : 0.5f;
            { pg8::Gemm g{A, B, MFULL, DM, K, K}; pg8::StaticOrder S; S.init(MFULL, DM, G, (int)blockIdx.x);
              pg8::EpiResid E{HB, ssn, alpha};
              pg8::gemm_phase<pg8::EpiResid, pg8::StaticOrder, true, true>((LAS unsigned char*)lds, g, S, E); }
            float* slab = (float*)(ws + WS_SLAB);
            { pg8::Gemm g{A + (size_t)MFULL * K, B, 256, DM, K, KSPLIT}; pg8::SplitOrder S; S.init(DM, K / KSPLIT, KSPLIT, G, (int)blockIdx.x);
              pg8::EpiSlab E{slab, TROWS};
              pg8::gemm_phase<pg8::EpiSlab, pg8::SplitOrder, true, true>((LAS unsigned char*)lds, g, S, E); }
            xcd_barrier(bar);
            { const int nsl = K / KSPLIT; const int ltid_ = ltid();
              for (int i = blockIdx.x * 512 + ltid_; i < TROWS * (DM / 8); i += G * 512) { const int row = i / (DM / 8), c8 = (i % (DM / 8)) * 8;
                  f32x4 s0 = {0.f, 0.f, 0.f, 0.f}, s1 = {0.f, 0.f, 0.f, 0.f};
                  for (int s = 0; s < nsl; ++s) { const float* p = slab + ((size_t)s * TROWS + row) * DM + c8; s0 += *(const f32x4*)p; s1 += *(const f32x4*)(p + 4); }
                  bf16_t* hp = HB + (size_t)(MFULL + row) * DM + c8; const v4u h = *(const v4u*)hp;
                  const float n0 = pg8::bf_lo(h.x) + alpha * s0.x, n1 = pg8::bf_hi(h.x) + alpha * s0.y, n2 = pg8::bf_lo(h.y) + alpha * s0.z, n3 = pg8::bf_hi(h.y) + alpha * s0.w;
                  const float n4 = pg8::bf_lo(h.z) + alpha * s1.x, n5 = pg8::bf_hi(h.z) + alpha * s1.y, n6 = pg8::bf_lo(h.w) + alpha * s1.z, n7 = pg8::bf_hi(h.w) + alpha * s1.w;
                  v4u w; w.x = pk2(n0, n1); w.y = pk2(n2, n3); w.z = pk2(n4, n5); w.w = pk2(n6, n7); *(v4u*)hp = w;
                  const float sq = wave_sum((n0 * n0 + n1 * n1) + (n2 * n2 + n3 * n3) + (n4 * n4 + n5 * n5) + (n6 * n6 + n7 * n7));
                  if ((ltid_ & 63) == 0) atomicAdd(ssn + MFULL + row, sq); } }
        } else if (ph == 3 && PHON(3)) {
            pg8::Gemm g{HB, WPTR(WS_WIN), MPAD, NIN, DM, DM}; pg8::StaticOrder S; S.init(MPAD, NIN, G, (int)blockIdx.x);
            pg8::EpiScale E{QKV, ssb + MPAD, NIN};
            pg8::gemm_phase<pg8::EpiScale, pg8::StaticOrder, true, true>((LAS unsigned char*)lds, g, S, E);
        } else if (ph == 4 && PHON(4)) { TIDS;
            const float* qkg = kargs()->in[11];
            for (int r = gw; r < MREAL; r += NGW) {
                const int t = r < 4 * LP ? r % LP : r - 4 * LP;
                float c = 1.f, sn = 0.f;
                if (t >= NMETA) { const int pp = t - NMETA, rowi = pp >> 6, coli = pp & 63;
                    const float f = __builtin_amdgcn_exp2f(-(float)(lane & 31) * (13.287712379549449f / 32.0f));
                    const float ang = (float)(lane < 32 ? rowi : coli) * f; float rev = ang * 0.15915494309189535f; rev -= floorf(rev);
                    sn = __builtin_amdgcn_sinf(rev); c = __builtin_amdgcn_cosf(rev); }
                bf16_t* base = QKV + (size_t)r * NIN;
                unsigned wv[10];
#pragma unroll
                for (int hh = 0; hh < 10; ++hh) wv[hh] = *((const unsigned*)(base + (hh < 8 ? 3072 + hh * 128 : 4096 + (hh - 8) * 128)) + lane);
                const float gq0 = qkg[2 * lane], gq1 = qkg[2 * lane + 1], gk0 = qkg[128 + 2 * lane], gk1 = qkg[128 + 2 * lane + 1];
#pragma unroll
                for (int hh = 0; hh < 10; ++hh) { const int off = hh < 8 ? 3072 + hh * 128 : 4096 + (hh - 8) * 128; const float qs = hh < 8 ? QSCALE_B : 1.f;
                    const float x0 = pg8::bf_lo(wv[hh]), x1 = pg8::bf_hi(wv[hh]);
                    const float s2 = wave_sum(x0 * x0 + x1 * x1); const float rn = __builtin_amdgcn_rsqf(s2 * (1.0f / 128.0f) + EPS);
                    const float y0 = x0 * rn * (hh < 8 ? gq0 : gk0), y1 = x1 * rn * (hh < 8 ? gq1 : gk1);
                    *((unsigned*)(base + off) + lane) = pk2((y0 * c - y1 * sn) * qs, (y0 * sn + y1 * c) * qs); }
            }
        } else if (ph == 5 && PHON(5)) { TIDS;
            char* L = (char*)lds; int* misc = (int*)(L + att::OFF_MISC); float* lut = (float*)(L + att::OFF_LUT);
            const int home = (int)((unsigned)__builtin_amdgcn_s_getreg((3 << 11) | 20) & 7u);
            const float lam = ((const float*)ctl)[CW_LAM];
            for (int qq = 0; qq < 8; ++qq) { const int queue = (home + qq) & 7;
                for (;;) {
                    __syncthreads();
                    if (ltid() == 0) misc[0] = (int)atomicAdd(ctl + CW_CNT + 64 * (queue + 8 * (pi & 1)), 1u);
                    __syncthreads();
                    const int ui = misc[0]; if (ui >= QUNITS) break;
                    int seq, head, qb;
                    bool virt = false;
                    if (ui < 64) { seq = 4; head = queue; qb = ui; } else if (ui < 128) { seq = 4; head = 8 + queue; qb = ui - 64; }
                    else if (ui == 128) { seq = 4; head = queue; qb = 64; virt = true; } else if (ui == 129) { seq = 4; head = 8 + queue; qb = 64; }
                    else if (ui < 162) { const int j = ui - 130; seq = j >> 3; qb = j & 7; head = queue; } else if (ui < 166) { seq = ui - 162; qb = 8; head = queue; virt = true; }
                    else { const int j = ui - 166; seq = j / 9; qb = j % 9; head = 8 + queue; }
                    const int rowbase = seq * LP, Lk = seq < 4 ? LP : LS, NT = seq < 4 ? NTP : NTS, q0 = qb * 256, qw0 = q0 + wave * 32;
                    const int nact = min(8, (Lk - q0 + 31) >> 5);
                    const bf16_t* Qs = QKV + (size_t)rowbase * NIN; bf16_t* Ys = Y + (size_t)rowbase * DM;
                    att::f32x16 o[4];
                    if (virt) {
                        for (int i = ltid(); i < att::LUTN; i += 512) lut[i] = ((const float*)ctl)[CW_LUT + head * att::LUTN + i];
                        __syncthreads();
                        att::attn_pass<128, true, true>(Qs + (size_t)q0 * NIN + head * 128, Qs + 1024 + head * 128, Qs + 2048 + head * 128, Lk, NT, q0, lut, o, L, 1);
                        if (wave == 0) { const int le_ = ltid() & 63, r32 = le_ & 31, hi = le_ >> 5;
                            const float* sg = kargs()->in[10];
                            float g4[4];
#pragma unroll
                            for (int d = 0; d < 4; ++d) g4[d] = sg[d * 32 + r32] * 0.8f;
#pragma unroll
                            for (int r = 0; r < 8; ++r) {
                                float dv[4];
#pragma unroll
                                for (int d = 0; d < 4; ++d) dv[d] = o[d][r] - lam * o[d][r + 8];
                                float s2 = (dv[0] * dv[0] + dv[1] * dv[1]) + (dv[2] * dv[2] + dv[3] * dv[3]);
                                s2 += SWZ(s2, 0x041F); s2 += SWZ(s2, 0x081F); s2 += SWZ(s2, 0x101F); s2 += SWZ(s2, 0x201F); s2 += SWZ(s2, 0x401F);
                                const float rn = __builtin_amdgcn_rsqf(s2 * (1.0f / 128.0f) + EPS); const int row = q0 + att::crow(r, hi);
                                if (row < Lk) { bf16_t* yp = Ys + (size_t)row * DM + head * 128 + r32;
#pragma unroll
                                    for (int d = 0; d < 4; ++d) ((__attribute__((address_space(1))) bf16_t*)yp)[d * 32] = (bf16_t)f2bf(dv[d] * rn * g4[d]); } } }
                    } else if (head < 8) {
                        for (int i = ltid(); i < att::LUTN; i += 512) lut[i] = ((const float*)ctl)[CW_LUT + head * att::LUTN + i];
#pragma unroll 1
                        for (int pass = 0; pass < 2; ++pass) {
                            __syncthreads();
                            att::attn_pass<64, true>(Qs + (size_t)q0 * NIN + head * 128 + pass * 64, Qs + 1024 + head * 128 + pass * 64, Qs + 2048 + head * 128, Lk, NT, qw0, lut, o, L, nact);
                            if (pass == 0) { unsigned* st = (unsigned*)(L + att::OFF_O1) + wave * 2048 + (ltid() & 63);
#pragma unroll
                                for (int d = 0; d < 4; ++d)
#pragma unroll
                                    for (int r = 0; r < 16; r += 2) st[(d * 8 + (r >> 1)) * 64] = att::cvtpk(o[d][r], o[d][r + 1]);
                            }
                        }
                        asm volatile("s_waitcnt lgkmcnt(0)" ::: "memory");
                        const int le_ = ltid() & 63, r32 = le_ & 31, hi = le_ >> 5;
                        const float* sg = kargs()->in[10]; const unsigned* st = (const unsigned*)(L + att::OFF_O1) + wave * 2048 + (ltid() & 63);
#pragma unroll
                        for (int d = 0; d < 4; ++d)
#pragma unroll
                            for (int r = 0; r < 16; r += 2) { const unsigned w = st[(d * 8 + (r >> 1)) * 64]; o[d][r] = pg8::bf_lo(w) - lam * o[d][r]; o[d][r + 1] = pg8::bf_hi(w) - lam * o[d][r + 1]; }
                        float g4[4];
#pragma unroll
                        for (int d = 0; d < 4; ++d) g4[d] = sg[d * 32 + r32] * 0.8f;
#pragma unroll
                        for (int r = 0; r < 16; ++r) { float s2 = (o[0][r] * o[0][r] + o[1][r] * o[1][r]) + (o[2][r] * o[2][r] + o[3][r] * o[3][r]);
                            s2 += SWZ(s2, 0x041F); s2 += SWZ(s2, 0x081F); s2 += SWZ(s2, 0x101F); s2 += SWZ(s2, 0x201F); s2 += SWZ(s2, 0x401F);
                            const float rn = __builtin_amdgcn_rsqf(s2 * (1.0f / 128.0f) + EPS); const int row = qw0 + att::crow(r, hi);
                            if (row < Lk) { bf16_t* yp = Ys + (size_t)row * DM + head * 128 + r32;
#pragma unroll
                                for (int d = 0; d < 4; ++d) ((__attribute__((address_space(1))) bf16_t*)yp)[d * 32] = (bf16_t)f2bf(o[d][r] * rn * g4[d]); } }
                    } else {
                        const int hq = head - 8, kvh = hq >> 2;
                        __syncthreads();
                        att::attn_pass<128, false>(Qs + (size_t)q0 * NIN + 3072 + hq * 128, Qs + 4096 + kvh * 128, Qs + 4352 + kvh * 128, Lk, NT, qw0, lut, o, L, nact);
                        const int le_ = ltid() & 63, r32 = le_ & 31, hi = le_ >> 5;
#pragma unroll
                        for (int r = 0; r < 16; ++r) { const int row = qw0 + att::crow(r, hi);
                            if (row < Lk) { bf16_t* yp = Ys + (size_t)row * DM + 1024 + hq * 128 + r32;
#pragma unroll
                                for (int d = 0; d < 4; ++d) ((__attribute__((address_space(1))) bf16_t*)yp)[d * 32] = (bf16_t)f2bf(o[d][r]); } }
                    }
                }
            }
            { const int lane2 = ltid() & 63; LAS float* scr = (LAS float*)((LAS unsigned char*)lds + wave * 16640); int* misc2 = (int*)((char*)lds + att::OFF_MISC);
              for (;;) {
                  __syncthreads();
                  if (ltid() == 0) misc2[0] = (int)atomicAdd(ctl + CW_TRC, 1u);
                  __syncthreads();
                  const int tu = misc2[0]; if (tu >= NTRU) break;
                  const int base = tu * 64 + wave * 8;
                  for (int k = 0; k < 8; ++k) { int r = base + k; if (r >= NDEF) break;
                      if (r < I_FI) { tr_item(kargs()->in[14], DM, 2 * DFF, WPTR(WS_W2IN), kargs()->in[13], 1, scr, r, lane2); continue; } r -= I_FI;
                      if (r < I_FO) { tr_item(kargs()->in[15], DFF, DM, WPTR(WS_W2OUT), nullptr, 0, scr, r, lane2); continue; } r -= I_FO;
                      tr_item(kargs()->in[12], DM, DM, WPTR(WS_WOUT), nullptr, 0, scr, r, lane2); } } }
        } else if (ph == 9 && PHON(9)) { TIDS;
            const float* fg = kargs()->in[16]; const float* ss3 = ssb + 3 * MPAD;
            for (int ro = gw; ro < NOUT; ro += NGW) {
                const int s = ro < 8192 ? ro >> 11 : 4, r = ro + NMETA * (s + 1);
                const float ri = __builtin_amdgcn_rsqf(ss3[r] * (1.0f / 2048.0f) + EPS);
                const v4u* hp = (const v4u*)(HB + (size_t)r * DM) + lane; float* op = kargs()->out + (size_t)ro * DM + 8 * lane; const float* gp = fg + 8 * lane;
#pragma unroll
                for (int j = 0; j < 4; ++j) { const v4u h = __builtin_nontemporal_load(hp + 64 * j); const f32x4 g0 = *(const f32x4*)(gp + 512 * j), g1 = *(const f32x4*)(gp + 512 * j + 4);
                    f32x4 a, b; a.x = pg8::bf_lo(h.x) * ri * g0.x; a.y = pg8::bf_hi(h.x) * ri * g0.y; a.z = pg8::bf_lo(h.y) * ri * g0.z; a.w = pg8::bf_hi(h.y) * ri * g0.w;
                    b.x = pg8::bf_lo(h.z) * ri * g1.x; b.y = pg8::bf_hi(h.z) * ri * g1.y; b.z = pg8::bf_lo(h.w) * ri * g1.z; b.w = pg8::bf_hi(h.w) * ri * g1.w;
                    __builtin_nontemporal_store(a, (f32x4*)(op + 512 * j)); __builtin_nontemporal_store(b, (f32x4*)(op + 512 * j + 4)); }
            }
        }
        if (pi + 1 < args.ph_hi) { if (args.ph_lo > 4096) grid.sync();   xcd_barrier(bar); }
    }
}

extern "C" void kernel_launch(void* const* d_in, const int* in_sizes, int n_in, void* d_out, int out_size, void* d_ws, size_t ws_size, hipStream_t stream) {
    static int grid = 0;
    if (grid == 0) {
        if (n_in != 17 || out_size != NOUT * DM || ws_size < WS_END) { fprintf(stderr, "kernel_launch: unexpected shapes (n_in %d out %d ws %zu need %zu)\n", n_in, out_size, ws_size, (size_t)WS_END); grid = -1; return; }
        int dev = 0, cus = 0, per_cu = 0;
        hipGetDevice(&dev); hipDeviceGetAttribute(&cus, hipDeviceAttributeMultiprocessorCount, dev);
        if (hipFuncSetAttribute((const void*)fwd_kernel, hipFuncAttributeMaxDynamicSharedMemorySize, LDS_BYTES) != hipSuccess) { fprintf(stderr, "kernel_launch: hipFuncSetAttribute failed\n"); grid = -1; return; }
        if (hipOccupancyMaxActiveBlocksPerMultiprocessor(&per_cu, (const void*)fwd_kernel, NWAVES * 64, LDS_BYTES) != hipSuccess || per_cu < 1) { fprintf(stderr, "kernel_launch: occupancy query says %d\n", per_cu); per_cu = 1; }
        (void)hipGetLastError();
        grid = cus * 1;
    }
    if (grid < 0) return;
    if (hipMemsetAsync((char*)d_ws + WS_CTL, 0, CTL_ZERO_BYTES, stream) != hipSuccess) { fprintf(stderr, "kernel_launch: memset failed\n"); return; }
    Args a{};
    for (int i = 0; i < 17; ++i) a.in[i] = (const float*)d_in[i];
    a.out = (float*)d_out; a.ws = (unsigned char*)d_ws;
#if MK_PER_PHASE
    for (int ph = 0; ph < MK_NSEQ; ++ph) { a.ph_lo = ph; a.ph_hi = ph + 1; hipLaunchKernelGGL(fwd_kernel, dim3(grid), dim3(NWAVES * 64), LDS_BYTES, stream, a); }
#else
    a.ph_lo = 0; a.ph_hi = MK_NSEQ;
    void* kargs[] = {&a};
    hipError_t e = hipLaunchCooperativeKernel((const void*)fwd_kernel, dim3(grid), dim3(NWAVES * 64), kargs, LDS_BYTES, stream);
    if (e != hipSuccess) fprintf(stderr, "kernel_launch: cooperative launch failed: %s (grid %d)\n", hipGetErrorString(e), grid);
#endif
}
```

```cpp
#include <hip/hip_runtime.h>
#include <hip/hip_cooperative_groups.h>
#include <cstdio>
#include <cstdint>
#include <cmath>
namespace cg = cooperative_groups;
#ifndef MK_PER_PHASE
#define MK_PER_PHASE 0
#endif
__device__ __forceinline__ int ltid() { int t = threadIdx.x; asm volatile("" : "+v"(t)); return t; }
#define LAS __attribute__((address_space(3)))
namespace pg8 {
#define PG8_LAS __attribute__((address_space(3)))
typedef unsigned short bf16_t;
typedef short bf16x8 __attribute__((ext_vector_type(8)));
typedef float f32x4 __attribute__((ext_vector_type(4)));
typedef unsigned u32x4 __attribute__((ext_vector_type(4)));
constexpr int BM = 256, BK = 64, HALF = 128, HTB = HALF * BK * 2  , STAGE_BYTES = 8 * HTB, NXCD = 8, WGM = 4;

__host__ __device__ __forceinline__ int lds_byte(int r, int c) { const int st = (r >> 4) * 2 + (c >> 5), rr = r & 15, cc = c & 31, ob = rr * 64 + cc * 2; return st * 1024 + (ob ^ (((ob >> 9) & 1) << 5)); }
__host__ __device__ __forceinline__ void stage_rc(int b, int& R, int& C) { const int st = b / 1024, sb = b % 1024, swz = sb ^ (((sb >> 9) & 1) << 5); R = (st >> 1) * 16 + swz / 64; C = (st & 1) * 32 + (swz % 64) / 2; }
__host__ __device__ __forceinline__ int perm32(int rho) { const int n = rho >> 4, i = rho & 15; return 8 * (i >> 2) + 4 * n + (i & 3); }

struct Unit { int pm, pn; };
struct Gemm { const bf16_t* A; const bf16_t* Bt; int M, N, K, Kloop; };

struct StaticOrder {
    int nM, nN, nwg, G, c;
    __host__ __device__ void init(int M, int N, int G_, int c_) { nM = M / BM; nN = N / BM; nwg = nM * nN; G = G_; c = c_; }
    __host__ __device__ bool next(int i, Unit& u) const {
        const long L = (long)i * G + c; if (L >= nwg) return false;
        int wgid = (int)L; { const int q = nwg / NXCD, r = nwg % NXCD, xcd = wgid % NXCD, off = wgid / NXCD; wgid = (xcd < r ? xcd * (q + 1) : r * (q + 1) + (xcd - r) * q) + off; }
        const int nig = WGM * nN, gid = wgid / nig, fm = gid * WGM, gsz = (nM - fm) < WGM ? (nM - fm) : WGM;
        u.pm = fm + ((wgid % nig) % gsz); u.pn = (wgid % nig) / gsz; return true;
    }
    __device__ __forceinline__ size_t offA(const Unit& u, size_t tstep) const { return (size_t)u.pm * tstep; }
    __device__ __forceinline__ size_t offB(const Unit& u, size_t tstep) const { return (size_t)u.pn * tstep; }
    __device__ __forceinline__ void a_ready(const Unit&) const {}
    __device__ __forceinline__ void done(const Unit&) const {}
};
struct SplitOrder {
    int nunits, G, c, nN, ksbytes;
    __host__ __device__ void init(int N, int nsplit, int KS, int G_, int c_) { nN = N / BM; nunits = nN * nsplit; G = G_; c = c_; ksbytes = KS * 2; }
    __host__ __device__ bool next(int i, Unit& u) const { const long L = (long)i * G + c; if (L >= nunits) return false; u.pm = (int)L / nN; u.pn = (int)L % nN; return true; }
    __device__ __forceinline__ size_t offA(const Unit& u, size_t) const { return (size_t)u.pm * ksbytes; }
    __device__ __forceinline__ size_t offB(const Unit& u, size_t tstep) const { return (size_t)u.pn * tstep + (size_t)u.pm * ksbytes; }
    __device__ __forceinline__ void a_ready(const Unit&) const {}
    __device__ __forceinline__ void done(const Unit&) const {}
};
__device__ __forceinline__ unsigned cvt_pk_bf16(float lo, float hi) { unsigned r; asm volatile("v_cvt_pk_bf16_f32 %0, %1, %2" : "=v"(r) : "v"(lo), "v"(hi)); return r; }
typedef float f32x2 __attribute__((ext_vector_type(2)));
template <class Epi, class Sched, bool ALIGN_EPI = false, bool SP2 = false>
__device__ __forceinline__ void gemm_phase(PG8_LAS unsigned char* lds, const Gemm g, const Sched& S, const Epi& E) {
    const int tid = ltid(), wid = __builtin_amdgcn_readfirstlane(tid >> 6), lane = tid & 63, wr = wid >> 2, wc = wid & 3, fr = lane & 15, fq = lane >> 4;
    const int K = g.K  , nt = g.Kloop / BK  ;
    unsigned voffA[2], voffB[2];
#pragma unroll
    for (int i = 0; i < 2; ++i) { int R, C; stage_rc(tid * 16 + i * 8192, R, C); const int Rb = Epi::PERM ? ((R & ~31) + perm32(R & 31)) : R;
        voffA[i] = (unsigned)(R * K + C) * 2u; voffB[i] = (unsigned)(Rb * K + C) * 2u; }
    const size_t kstep = (size_t)(BK * 2);
    const size_t hstep = (size_t)HALF * K * 2;
    const size_t tstep = 2 * hstep;
    const unsigned ldsw = (unsigned)wid * 1024u;
    const int aoff = lds_byte(wr * 64 + fr, fq * 8), boff = lds_byte(wc * 32 + fr, fq * 8);
#define PG8_SA(b, h) (((b) * 2 + (h)) * HTB)
#define PG8_SB(b, h) ((4 + (b) * 2 + (h)) * HTB)
#define PG8_STAGE(bufoff, gbase, voff) do { _Pragma("unroll") for (int _i = 0; _i < 2; ++_i) \
        __builtin_amdgcn_global_load_lds((const unsigned*)((const char*)(gbase) + (voff)[_i]), (PG8_LAS unsigned*)(lds + (bufoff) + ldsw + _i * 8192), 16, 0, 0); } while (0)
#define PG8_LDA(dst, b, h) do { _Pragma("unroll") for (int m = 0; m < 4; ++m) _Pragma("unroll") for (int k = 0; k < 2; ++k) dst[m][k] = *(const PG8_LAS bf16x8*)(lds + PG8_SA(b, h) + aoff + m * 2048 + k * 1024); } while (0)
#define PG8_LDB(dst, b, h) do { _Pragma("unroll") for (int n = 0; n < 2; ++n) _Pragma("unroll") for (int k = 0; k < 2; ++k) dst[n][k] = *(const PG8_LAS bf16x8*)(lds + PG8_SB(b, h) + boff + n * 2048 + k * 1024); } while (0)
#define PG8_MMA(ai, bj, At, Bt) do { __builtin_amdgcn_s_setprio(1); _Pragma("unroll") for (int m = 0; m < 4; ++m) _Pragma("unroll") for (int n = 0; n < 2; ++n) _Pragma("unroll") for (int k = 0; k < 2; ++k) \
        acc[ai][bj][m][n] = __builtin_amdgcn_mfma_f32_16x16x32_bf16(Bt[n][k], At[m][k], acc[ai][bj][m][n], 0, 0, 0); __builtin_amdgcn_s_setprio(0); } while (0)
#define PG8_WAIT_V(n) asm volatile("s_waitcnt vmcnt(" #n ")" ::: "memory")
#define PG8_WAIT_L(n) asm volatile("s_waitcnt lgkmcnt(" #n ")" ::: "memory")
#define PG8_BAR __builtin_amdgcn_s_barrier()
#define PG8_SCHED __builtin_amdgcn_sched_barrier(0)
    Unit cur, nxt; int ui = 0;
    if (!S.next(0, cur)) return;
    f32x4 acc[2][2][4][2];
#pragma unroll
    for (int a = 0; a < 2; ++a)
#pragma unroll
        for (int b = 0; b < 2; ++b)
#pragma unroll
            for (int m = 0; m < 4; ++m)
#pragma unroll
                for (int n = 0; n < 2; ++n) { float z_ = 0.f; asm volatile("" : "+v"(z_)); acc[a][b][m][n] = (f32x4){z_, z_, z_, z_}; }
    bf16x8 At[4][2], B0[2][2], B1[2][2];
    { short zs_ = 0; asm volatile("" : "+v"(zs_)); const bf16x8 zq_ = {zs_, zs_, zs_, zs_, zs_, zs_, zs_, zs_};
#pragma unroll
      for (int m = 0; m < 4; ++m) { At[m][0] = zq_; At[m][1] = zq_; }
#pragma unroll
      for (int n = 0; n < 2; ++n) { B0[n][0] = zq_; B0[n][1] = zq_; B1[n][0] = zq_; B1[n][1] = zq_; } }
    const char* cA = (const char*)g.A + S.offA(cur, tstep); const char* cB = (const char*)g.Bt + S.offB(cur, tstep);
    S.a_ready(cur);
    if constexpr (SP2) {
        PG8_STAGE(PG8_SB(0, 0), cB, voffB); PG8_STAGE(PG8_SB(0, 1), cB + hstep, voffB); PG8_STAGE(PG8_SA(0, 0), cA, voffA); PG8_STAGE(PG8_SA(0, 1), cA + hstep, voffA);
        if (wr == 1) PG8_BAR;
        PG8_WAIT_V(2); PG8_BAR;
        PG8_STAGE(PG8_SB(1, 0), cB + kstep, voffB); PG8_STAGE(PG8_SA(1, 0), cA + kstep, voffA); PG8_STAGE(PG8_SB(1, 1), cB + hstep + kstep, voffB);
        PG8_WAIT_V(6); PG8_BAR;
    } else {
        PG8_STAGE(PG8_SB(0, 0), cB, voffB); PG8_STAGE(PG8_SA(0, 0), cA, voffA); PG8_STAGE(PG8_SB(0, 1), cB + hstep, voffB); PG8_STAGE(PG8_SA(0, 1), cA + hstep, voffA);
        if (wr == 1) PG8_BAR;
        PG8_WAIT_V(4); PG8_BAR;
        PG8_STAGE(PG8_SB(1, 0), cB + kstep, voffB); PG8_STAGE(PG8_SA(1, 0), cA + kstep, voffA); PG8_STAGE(PG8_SB(1, 1), cB + hstep + kstep, voffB);
        PG8_WAIT_V(6); PG8_BAR;
    }
    for (;;) {
        const bool has_next = S.next(ui + 1, nxt);
        const char* nA = has_next ? (const char*)g.A + S.offA(nxt, tstep) : cA; const char* nB = has_next ? (const char*)g.Bt + S.offB(nxt, tstep) : cB;
        for (int t = 0; t < nt; t += 2) {
            const bool last = (t == nt - 2);
            const char* a1 = cA + (size_t)(t + 1) * kstep;
            const char* a2 = last ? nA : cA + (size_t)(t + 2) * kstep; const char* b2 = last ? nB : cB + (size_t)(t + 2) * kstep;
            const char* a3 = a2 + kstep; const char* b3 = b2 + kstep;
            if (last && has_next) S.a_ready(nxt);
            if constexpr (SP2) {
            PG8_LDB(B0, 0, 0); PG8_LDB(B1, 0, 1); PG8_SCHED; PG8_LDA(At, 0, 0); PG8_STAGE(PG8_SA(1, 1), a1 + hstep, voffA);
            PG8_WAIT_V(8); PG8_WAIT_L(0); PG8_BAR; PG8_MMA(0, 0, At, B0); PG8_MMA(0, 1, At, B1); PG8_BAR; PG8_SCHED;
            PG8_LDA(At, 0, 1); PG8_STAGE(PG8_SB(0, 0), b2, voffB); PG8_STAGE(PG8_SB(0, 1), b2 + hstep, voffB); PG8_STAGE(PG8_SA(0, 0), a2, voffA);
            PG8_WAIT_V(8); PG8_WAIT_L(0); PG8_BAR; PG8_MMA(1, 0, At, B0); PG8_MMA(1, 1, At, B1); PG8_BAR; PG8_SCHED;
            PG8_LDB(B0, 1, 0); PG8_LDB(B1, 1, 1); PG8_SCHED; PG8_LDA(At, 1, 0); PG8_STAGE(PG8_SA(0, 1), a2 + hstep, voffA);
            PG8_WAIT_V(8); PG8_WAIT_L(0); PG8_BAR; PG8_MMA(0, 0, At, B0); PG8_MMA(0, 1, At, B1); PG8_BAR; PG8_SCHED;
            PG8_LDA(At, 1, 1); PG8_STAGE(PG8_SB(1, 0), b3, voffB); PG8_STAGE(PG8_SB(1, 1), b3 + hstep, voffB); PG8_STAGE(PG8_SA(1, 0), a3, voffA);
            PG8_WAIT_V(8); PG8_WAIT_L(0); PG8_BAR; PG8_MMA(1, 0, At, B0); PG8_MMA(1, 1, At, B1); PG8_BAR; PG8_SCHED;
            } else {
            PG8_LDB(B0, 0, 0); PG8_SCHED; PG8_LDA(At, 0, 0); PG8_STAGE(PG8_SA(1, 1), a1 + hstep, voffA);
            PG8_WAIT_L(8); PG8_BAR; PG8_WAIT_L(0); PG8_MMA(0, 0, At, B0); PG8_BAR; PG8_SCHED;
            PG8_LDB(B1, 0, 1); PG8_STAGE(PG8_SB(0, 0), b2, voffB);
            PG8_BAR; PG8_WAIT_L(0); PG8_MMA(0, 1, At, B1); PG8_BAR;
            PG8_LDA(At, 0, 1); PG8_STAGE(PG8_SA(0, 0), a2, voffA);
            PG8_BAR; PG8_WAIT_L(0); PG8_MMA(1, 0, At, B0); PG8_BAR; PG8_SCHED;
            PG8_STAGE(PG8_SB(0, 1), b2 + hstep, voffB);
            PG8_WAIT_V(6); PG8_BAR; PG8_MMA(1, 1, At, B1); PG8_BAR;
            PG8_LDB(B0, 1, 0); PG8_SCHED; PG8_LDA(At, 1, 0); PG8_STAGE(PG8_SA(0, 1), a2 + hstep, voffA);
            PG8_WAIT_L(8); PG8_BAR; PG8_WAIT_L(0); PG8_MMA(0, 0, At, B0); PG8_BAR; PG8_SCHED;
            PG8_LDB(B1, 1, 1); PG8_STAGE(PG8_SB(1, 0), b3, voffB);
            PG8_BAR; PG8_WAIT_L(0); PG8_MMA(0, 1, At, B1); PG8_BAR;
            PG8_LDA(At, 1, 1); PG8_STAGE(PG8_SA(1, 0), a3, voffA);
            PG8_BAR; PG8_WAIT_L(0); PG8_MMA(1, 0, At, B0); PG8_BAR; PG8_SCHED;
            PG8_STAGE(PG8_SB(1, 1), b3 + hstep, voffB);
            PG8_WAIT_V(6); PG8_BAR; PG8_MMA(1, 1, At, B1); PG8_BAR;
            }
        }
        if constexpr (ALIGN_EPI) { if (wr == 0) PG8_BAR; }
        if constexpr (!Epi::AFTER_DRAIN) { E(acc, cur, wr, wc, fr, fq); S.done(cur); }
        if (!has_next) break;
#pragma unroll
        for (int a = 0; a < 2; ++a)
#pragma unroll
            for (int b = 0; b < 2; ++b)
#pragma unroll
                for (int m = 0; m < 4; ++m)
#pragma unroll
                    for (int n = 0; n < 2; ++n) { float z_ = 0.f; asm volatile("" : "+v"(z_)); acc[a][b][m][n] = (f32x4){z_, z_, z_, z_}; }
        cur = nxt; cA = nA; cB = nB; ++ui;
        if constexpr (ALIGN_EPI) { if (wr == 1) PG8_BAR; }
    }
    PG8_WAIT_V(0);
    if constexpr (!ALIGN_EPI) { if (wr == 0) PG8_BAR; }
    PG8_BAR;
    if constexpr (Epi::AFTER_DRAIN) { E.fused(acc, cur, wr, wc, fr, fq, lds, wid, lane); S.done(cur); }
#undef PG8_SA
#undef PG8_SB
#undef PG8_STAGE
#undef PG8_LDA
#undef PG8_LDB
#undef PG8_MMA
#undef PG8_WAIT_V
#undef PG8_WAIT_L
#undef PG8_BAR
#undef PG8_SCHED
}
}
namespace pg8 {
#define PG8_GAS __attribute__((address_space(1)))
__device__ __forceinline__ float bf_lo(unsigned w) { return __uint_as_float(w << 16); }
__device__ __forceinline__ float bf_hi(unsigned w) { return __uint_as_float(w & 0xffff0000u); }
__device__ __forceinline__ float silu_mul(float g, float u) { return g * __builtin_amdgcn_rcpf(1.0f + __builtin_amdgcn_exp2f(-1.4426950408889634f * g)) * u; }
struct EpiSwiglu {
    static constexpr bool PERM = true, AFTER_DRAIN = false;
    bf16_t* O; const float* ss; int ldo;
    __device__ __forceinline__ void operator()(const f32x4 (&acc)[2][2][4][2], const Unit& u, int wr, int wc, int fr, int fq) const {
        const int row0 = u.pm * BM + wr * 64 + fr, col0 = u.pn * HALF + wc * 32 + 8 * fq;
#pragma unroll
        for (int ai = 0; ai < 2; ++ai)
#pragma unroll
            for (int m = 0; m < 4; ++m) { const int row = row0 + ai * HALF + m * 16; const float ri = __builtin_amdgcn_rsqf(((const PG8_GAS float*)ss)[row] * (1.0f / 2048.0f) + 1e-6f);
                const f32x4 g0 = acc[ai][0][m][0] * ri, g1 = acc[ai][0][m][1] * ri, u0 = acc[ai][1][m][0] * ri, u1 = acc[ai][1][m][1] * ri;
                u32x4 w; w.x = cvt_pk_bf16(silu_mul(g0[0], u0[0]), silu_mul(g0[1], u0[1])); w.y = cvt_pk_bf16(silu_mul(g0[2], u0[2]), silu_mul(g0[3], u0[3]));
                w.z = cvt_pk_bf16(silu_mul(g1[0], u1[0]), silu_mul(g1[1], u1[1])); w.w = cvt_pk_bf16(silu_mul(g1[2], u1[2]), silu_mul(g1[3], u1[3]));
                *(PG8_GAS u32x4*)(O + (size_t)row * ldo + col0) = w; }
    }
};
struct EpiScale {
    static constexpr bool PERM = true, AFTER_DRAIN = false;
    bf16_t* O; const float* ss; int ldo;
    __device__ __forceinline__ void operator()(const f32x4 (&acc)[2][2][4][2], const Unit& u, int wr, int wc, int fr, int fq) const {
        const int row0 = u.pm * BM + wr * 64 + fr, col0 = u.pn * BM + wc * 32 + 8 * fq;
#pragma unroll
        for (int ai = 0; ai < 2; ++ai)
#pragma unroll
            for (int m = 0; m < 4; ++m) { const int row = row0 + ai * HALF + m * 16; const float ri = __builtin_amdgcn_rsqf(((const PG8_GAS float*)ss)[row] * (1.0f / 2048.0f) + 1e-6f);
#pragma unroll
                for (int bj = 0; bj < 2; ++bj) { const f32x4 v0 = acc[ai][bj][m][0] * ri, v1 = acc[ai][bj][m][1] * ri;
                    u32x4 w; w.x = cvt_pk_bf16(v0[0], v0[1]); w.y = cvt_pk_bf16(v0[2], v0[3]); w.z = cvt_pk_bf16(v1[0], v1[1]); w.w = cvt_pk_bf16(v1[2], v1[3]);
                    *(PG8_GAS u32x4*)(O + (size_t)row * ldo + col0 + bj * HALF) = w; } }
    }
};
struct EpiResid {
    static constexpr bool PERM = true, AFTER_DRAIN = false;
    bf16_t* H; float* ssn; float alpha;
    __device__ __forceinline__ void operator()(const f32x4 (&acc)[2][2][4][2], const Unit& u, int wr, int wc, int fr, int fq) const {
        const int row0 = u.pm * BM + wr * 64 + fr, col0 = u.pn * BM + wc * 32 + 8 * fq;
#pragma unroll
        for (int ai = 0; ai < 2; ++ai)
#pragma unroll
            for (int m = 0; m < 4; ++m) { const int row = row0 + ai * HALF + m * 16; float sq = 0.f;
#pragma unroll
                for (int bj = 0; bj < 2; ++bj) { bf16_t* hp = H + (size_t)row * 2048 + col0 + bj * HALF; const u32x4 h = *(const PG8_GAS u32x4*)hp;
                    const f32x4 a0 = acc[ai][bj][m][0], a1 = acc[ai][bj][m][1];
                    const float n0 = bf_lo(h.x) + alpha * a0[0], n1 = bf_hi(h.x) + alpha * a0[1], n2 = bf_lo(h.y) + alpha * a0[2], n3 = bf_hi(h.y) + alpha * a0[3];
                    const float n4 = bf_lo(h.z) + alpha * a1[0], n5 = bf_hi(h.z) + alpha * a1[1], n6 = bf_lo(h.w) + alpha * a1[2], n7 = bf_hi(h.w) + alpha * a1[3];
                    sq += (n0 * n0 + n1 * n1) + (n2 * n2 + n3 * n3) + (n4 * n4 + n5 * n5) + (n6 * n6 + n7 * n7);
                    u32x4 w; w.x = cvt_pk_bf16(n0, n1); w.y = cvt_pk_bf16(n2, n3); w.z = cvt_pk_bf16(n4, n5); w.w = cvt_pk_bf16(n6, n7);
                    *(PG8_GAS u32x4*)hp = w; }
                sq += __int_as_float(__builtin_amdgcn_ds_swizzle(__float_as_int(sq), 0x401F)); { auto rr = __builtin_amdgcn_permlane32_swap(__float_as_uint(sq), __float_as_uint(sq), false, false); sq = __uint_as_float(rr[0]) + __uint_as_float(rr[1]); }
                if (fq == 0) atomicAdd(ssn + row, sq); }
    }
};
struct EpiSlab {
    static constexpr bool PERM = true, AFTER_DRAIN = false;
    float* slab; int trows;
    __device__ __forceinline__ void operator()(const f32x4 (&acc)[2][2][4][2], const Unit& u, int wr, int wc, int fr, int fq) const {
        const int col0 = u.pn * BM + wc * 32 + 8 * fq;
#pragma unroll
        for (int m = 0; m < 4; ++m) { const int row = wr * 64 + m * 16 + fr;
            if (row < trows) { float* p = slab + ((size_t)u.pm * trows + row) * 2048 + col0;
#pragma unroll
                for (int bj = 0; bj < 2; ++bj) { *(PG8_GAS f32x4*)(p + bj * HALF) = acc[0][bj][m][0]; *(PG8_GAS f32x4*)(p + bj * HALF + 4) = acc[0][bj][m][1]; } } }
    }
};
}
namespace att {
typedef unsigned short bf16_t;
using bf16x8 = __attribute__((ext_vector_type(8))) short;
using s16x4  = __attribute__((ext_vector_type(4))) short;
using f32x16 = __attribute__((ext_vector_type(16))) float;
using u32x4  = __attribute__((ext_vector_type(4))) unsigned;
constexpr int NW = 8, QBLK = 32, KVBLK = 64, LD = 4608;
constexpr int SHM_V = KVBLK * 128 * 2, SHM_K = KVBLK * 128 * 2;
constexpr int OFF_V = 0, OFF_K = 2 * SHM_V, OFF_WS = OFF_K + 2 * SHM_K, OFF_LUT = OFF_WS + NW * 64 * 4, OFF_O1 = OFF_LUT + 2048, OFF_MISC = OFF_O1 + 65536, ATT_LDS = OFF_MISC + 1024;
constexpr int LUTN = 449, LUTC = 224;
constexpr float THR2 = 11.5f;
#define KSWZ(row, colB) ((row) * 256 + ((colB) ^ (((row) & 15) << 4)))
#define KSWZ64(row, colB) ((row) * 128 + ((colB) ^ ((((row) >> 1) & 7) << 4)))
#define SBAR() __builtin_amdgcn_sched_barrier(0)
#define GLD8(p) (*(const __attribute__((address_space(1))) bf16x8*)(p))
__device__ __forceinline__ int crow(int r, int hi) { return (r & 3) + 8 * (r >> 2) + 4 * hi; }
__device__ __forceinline__ unsigned cvtpk(float lo, float hi) { unsigned r; asm volatile("v_cvt_pk_bf16_f32 %0, %1, %2" : "=v"(r) : "v"(lo), "v"(hi)); return r; }

template <bool FIRST> __device__ __forceinline__ void partialSM(f32x16& p0, f32x16& p1, float& m_reg, float& alpha, f32x16& negm, float c_cur) {
  float pmax = p0[0];
#pragma unroll
  for (int r = 1; r < 16; ++r) pmax = fmaxf(pmax, p0[r]);
#pragma unroll
  for (int r = 0; r < 16; ++r) pmax = fmaxf(pmax, p1[r]);
  { auto rr = __builtin_amdgcn_permlane32_swap(__float_as_uint(pmax), __float_as_uint(pmax), false, false);
    pmax = fmaxf(__uint_as_float(rr[0]), __uint_as_float(rr[1])); }
  alpha = 1.f;
  if (FIRST || !__builtin_expect(__all(pmax <= THR2), 1)) {
    const float d = FIRST ? pmax : fmaxf(pmax, 0.f); m_reg += d; if (!FIRST) alpha = __builtin_amdgcn_exp2f(-d);
#pragma unroll
    for (int r = 0; r < 16; ++r) { p0[r] -= d; p1[r] -= d; }
    const float nm = c_cur - m_reg;
#pragma unroll
    for (int r = 0; r < 16; ++r) negm[r] = nm;
  }
#pragma unroll
  for (int r = 0; r < 16; ++r) p0[r] = __builtin_amdgcn_exp2f(p0[r]);
}
__device__ __forceinline__ void finishSM(f32x16& p0, f32x16& p1, float alpha, float& l_reg, bf16x8& pa0, bf16x8& pa1, bf16x8& pa2, bf16x8& pa3) {
#pragma unroll
  for (int r = 0; r < 16; ++r) p1[r] = __builtin_amdgcn_exp2f(p1[r]);
  float ps = 0;
#pragma unroll
  for (int r = 0; r < 16; ++r) ps += p0[r];
#pragma unroll
  for (int r = 0; r < 16; ++r) ps += p1[r];
  { auto rr = __builtin_amdgcn_permlane32_swap(__float_as_uint(ps), __float_as_uint(ps), false, false);
    ps = __uint_as_float(rr[0]) + __uint_as_float(rr[1]); }
  l_reg = l_reg * alpha + ps;
#define PK4(P, BASE, OUT) do { unsigned a0 = cvtpk(P[BASE + 0], P[BASE + 1]), a1 = cvtpk(P[BASE + 2], P[BASE + 3]);   \
    unsigned b0 = cvtpk(P[BASE + 4], P[BASE + 5]), b1 = cvtpk(P[BASE + 6], P[BASE + 7]);                              \
    auto r0 = __builtin_amdgcn_permlane32_swap(a0, b0, false, false); auto r1 = __builtin_amdgcn_permlane32_swap(a1, b1, false, false); \
    u32x4 w = {r0[0], r1[0], r0[1], r1[1]}; OUT = *reinterpret_cast<bf16x8*>(&w); } while (0)
  PK4(p0, 0, pa0); PK4(p0, 8, pa1); PK4(p1, 0, pa2); PK4(p1, 8, pa3);
#undef PK4
}
template <int DQK> __device__ __forceinline__ void qkt(f32x16& p0, f32x16& p1, const char* Ks, const bf16x8* qr, int r32, int hi, const f32x16& negm) {
#pragma unroll
  for (int d0 = 0; d0 < DQK / 16; ++d0) { const int cb = (d0 * 16 + hi * 8) * 2;
    const bf16x8 b0 = *reinterpret_cast<const bf16x8*>(Ks + (DQK == 128 ? KSWZ(r32, cb) : KSWZ64(r32, cb)));
    const bf16x8 b1 = *reinterpret_cast<const bf16x8*>(Ks + (DQK == 128 ? KSWZ(32 + r32, cb) : KSWZ64(32 + r32, cb)));
    if (d0 == 0) { p0 = __builtin_amdgcn_mfma_f32_32x32x16_bf16(b0, qr[0], negm, 0, 0, 0); p1 = __builtin_amdgcn_mfma_f32_32x32x16_bf16(b1, qr[0], negm, 0, 0, 0); }
    else { p0 = __builtin_amdgcn_mfma_f32_32x32x16_bf16(b0, qr[d0], p0, 0, 0, 0); p1 = __builtin_amdgcn_mfma_f32_32x32x16_bf16(b1, qr[d0], p1, 0, 0, 0); } }
}
__device__ __forceinline__ int v_st(int k, int c) { const int kk = (k & ~0xC) | ((k & 4) << 1) | ((k & 8) >> 1); return ((kk >> 3) * 4 + (c >> 5)) * 512 + ((kk & 7) * 32 + (c & 31)) * 2; }
__device__ __forceinline__ int v_rd_base(int lane) { return ((lane & 3) << 3) | (((lane >> 2) & 3) << 6) | (((lane >> 4) & 1) << 5) | (((lane >> 5) & 1) << 8); }
constexpr int v_rd_off(int d0, int ks, int half) { return d0 * 512 + ks * 4096 + half * 2048; }
template <int OFF> __device__ __forceinline__ s16x4 tr_read(int vb) {
  s16x4 r; asm volatile("ds_read_b64_tr_b16 %0, %1 offset:%2" : "=&v"(r) : "v"(vb), "i"(OFF) : "memory"); return r;
}
template <int D0> __device__ __forceinline__ void pv_one(f32x16& od, int vb, bf16x8 pa0, bf16x8 pa1, bf16x8 pa2, bf16x8 pa3) {
  const s16x4 l0 = tr_read<v_rd_off(D0, 0, 0)>(vb), h0 = tr_read<v_rd_off(D0, 0, 1)>(vb), l1 = tr_read<v_rd_off(D0, 1, 0)>(vb), h1 = tr_read<v_rd_off(D0, 1, 1)>(vb);
  const s16x4 l2 = tr_read<v_rd_off(D0, 2, 0)>(vb), h2 = tr_read<v_rd_off(D0, 2, 1)>(vb), l3 = tr_read<v_rd_off(D0, 3, 0)>(vb), h3 = tr_read<v_rd_off(D0, 3, 1)>(vb);
  asm volatile("s_waitcnt lgkmcnt(0)" ::: "memory"); SBAR();
#define PK(L, H) (bf16x8){L[0], L[1], L[2], L[3], H[0], H[1], H[2], H[3]}
  od = __builtin_amdgcn_mfma_f32_32x32x16_bf16(pa0, PK(l0, h0), od, 0, 0, 0);
  od = __builtin_amdgcn_mfma_f32_32x32x16_bf16(pa1, PK(l1, h1), od, 0, 0, 0);
  od = __builtin_amdgcn_mfma_f32_32x32x16_bf16(pa2, PK(l2, h2), od, 0, 0, 0);
  od = __builtin_amdgcn_mfma_f32_32x32x16_bf16(pa3, PK(l3, h3), od, 0, 0, 0);
#undef PK
}
__device__ __forceinline__ void pv_d0(f32x16* o, int vb, bf16x8 pa0, bf16x8 pa1, bf16x8 pa2, bf16x8 pa3) {
  pv_one<0>(o[0], vb, pa0, pa1, pa2, pa3); pv_one<1>(o[1], vb, pa0, pa1, pa2, pa3); pv_one<2>(o[2], vb, pa0, pa1, pa2, pa3); pv_one<3>(o[3], vb, pa0, pa1, pa2, pa3);
}
template <bool BIAS, bool VIRT> __device__ __forceinline__ void fixup(f32x16& p0, f32x16& p1, int t, int L, int qw0, int r32, int hi, const float* lut) {
  const int k0 = KVBLK * t;
  if (BIAS) {
    const int lo = k0 - (qw0 + (VIRT ? 15 : 31)), hi_ = k0 + 63 - qw0;
    if (!(lo >= 128 || hi_ <= -128)) {
      const float* lb = lut + (k0 - (qw0 + (VIRT ? (r32 & 15) : r32)) + LUTC + 4 * hi);
#pragma unroll
      for (int r = 0; r < 16; ++r) { const int kv = (r & 3) + 8 * (r >> 2); p0[r] += lb[kv]; p1[r] += lb[kv + 32]; }
    }
  }
  if (__builtin_expect(k0 + KVBLK > L, 0)) {
    asm volatile("" ::: "memory");
    const int kb = k0 + 4 * hi;
#pragma unroll
    for (int r = 0; r < 16; ++r) { const int kv = kb + (r & 3) + 8 * (r >> 2); if (kv >= L) p0[r] = -INFINITY; if (kv + 32 >= L) p1[r] = -INFINITY; }
  }
}
template <bool BIAS, bool VIRT> __device__ __forceinline__ float cinit(int t, int qw0, const float* lut) {
  if (!BIAS) return 0.f;
  const int k0 = KVBLK * t, lo = k0 - (qw0 + (VIRT ? 15 : 31)), hi_ = k0 + 63 - qw0;
  return lo >= 128 ? lut[LUTN - 1] : (hi_ <= -128 ? lut[0] : 0.f);
}
template <int DQK, bool BIAS, bool VIRT = false>
__device__ __forceinline__ void attn_pass(const bf16_t* __restrict__ Qb, const bf16_t* __restrict__ Kh, const bf16_t* __restrict__ Vh, int L, int NT, int qw0, const float* lut, f32x16 (&o)[4], char* lds, int nact) {
  const int tid = ltid(), wid = __builtin_amdgcn_readfirstlane(tid >> 6), lane = tid & 63, r32 = lane & 31, hi = lane >> 5;
  char* V_lds = lds + OFF_V; char* K_lds = lds + OFF_K;
  float* ws = (float*)(lds + OFF_WS) + wid * 64; float* li_l = ws; float* al_l = ws + 32;
  float m_reg = 0.f, l_reg = 0, c_cur = cinit<BIAS, VIRT>(0, qw0, lut);
  f32x16 negm;
#pragma unroll
  for (int r = 0; r < 16; ++r) negm[r] = c_cur;
#pragma unroll
  for (int d = 0; d < 4; ++d)
#pragma unroll
    for (int r = 0; r < 16; ++r) o[d][r] = 0.f;
  bf16x8 qr[DQK / 16];
  if (VIRT) {
    const int mp = r32 >> 4; const bf16_t* Qw = Qb + (long)(wid * 16 + (r32 & 15)) * LD + mp * 64 + hi * 8;
    short zs = 0; asm volatile("" : "+v"(zs)); const bf16x8 z = {zs, zs, zs, zs, zs, zs, zs, zs};
#pragma unroll
    for (int j = 0; j < 4; ++j) { const bf16x8 v = GLD8(Qw + j * 16); qr[j] = mp == 0 ? v : z; qr[(j + 4) % (DQK / 16)] = mp == 0 ? z : v; }
  } else {
    const bf16_t* Qw = Qb + (long)(wid * QBLK + r32) * LD + hi * 8;
#pragma unroll
    for (int d0 = 0; d0 < DQK / 16; ++d0) qr[d0] = __builtin_nontemporal_load((const __attribute__((address_space(1))) bf16x8*)(Qw + d0 * 16));
  }
  const int sr = tid >> 4, sc = (tid & 15) * 8, vst0 = v_st(sr, sc), vst1 = v_st(32 + sr, sc);
  const int kr = tid >> 3, kc = (tid & 7) * 8;
  const int vb0 = (int)(uintptr_t)V_lds + v_rd_base(lane);
  constexpr int SDEPTH = DQK == 128 ? 1 : 2;
  struct { bf16x8 vs0, vs1, ks0, ks1; } sr_[SDEPTH];
#define SLOAD(i, k0) do { sr_[i].vs0 = GLD8(&Vh[(long)((k0) + sr) * LD + sc]); sr_[i].vs1 = GLD8(&Vh[(long)((k0) + 32 + sr) * LD + sc]); \
    if (DQK == 128) { sr_[i].ks0 = GLD8(&Kh[(long)((k0) + sr) * LD + sc]); sr_[i].ks1 = GLD8(&Kh[(long)((k0) + 32 + sr) * LD + sc]); } \
    else { sr_[i].ks0 = GLD8(&Kh[(long)((k0) + kr) * LD + kc]); } } while (0)
#define SWRITE(b, i) do { *(bf16x8*)(V_lds + (b) * SHM_V + vst0) = sr_[i].vs0; *(bf16x8*)(V_lds + (b) * SHM_V + vst1) = sr_[i].vs1; \
    if (DQK == 128) { *(bf16x8*)(K_lds + (b) * SHM_K + KSWZ(sr, sc * 2)) = sr_[i].ks0; *(bf16x8*)(K_lds + (b) * SHM_K + KSWZ(32 + sr, sc * 2)) = sr_[i].ks1; } \
    else { *(bf16x8*)(K_lds + (b) * SHM_K + KSWZ64(kr, kc * 2)) = sr_[i].ks0; } } while (0)
#define SWAIT() do { if (SDEPTH == 1) asm volatile("s_waitcnt vmcnt(0)" ::: "memory"); else if (DQK == 128) asm volatile("s_waitcnt vmcnt(4)" ::: "memory"); else asm volatile("s_waitcnt vmcnt(3)" ::: "memory"); } while (0)
#define RESC(a) do { if (__any((a) < 1.f)) { if (hi == 0) al_l[r32] = (a); asm volatile("s_waitcnt lgkmcnt(0)" ::: "memory"); \
    _Pragma("unroll") for (int d = 0; d < 4; ++d) _Pragma("unroll") for (int r = 0; r < 16; ++r) o[d][r] *= al_l[crow(r, hi)]; } } while (0)
  f32x16 pA0, pA1, pB0, pB1; float alA, alB; bf16x8 pa0, pa1, pa2, pa3;
  constexpr int SE = 0, SO = SDEPTH - 1;
  if (wid >= nact) {
    SLOAD(SE, 0); asm volatile("s_waitcnt vmcnt(0)" ::: "memory"); SWRITE(0, SE); __syncthreads();
    SLOAD(SO, KVBLK); if (SDEPTH == 2) { if (2 < NT) SLOAD(SE, 2 * KVBLK); }
    SWAIT(); SWRITE(1, SO); __syncthreads();
    for (int j = 1; j + 1 < NT; j += 2) {
      SLOAD(SO, (j + SDEPTH) * KVBLK); __syncthreads(); SWAIT(); SWRITE(0, SE); __syncthreads();
      if (SDEPTH == 1 || j + 3 < NT) SLOAD(SE, (j + 1 + SDEPTH) * KVBLK);
      __syncthreads(); SWAIT(); SWRITE(1, SO); __syncthreads();
    }
    __syncthreads();
    return;
  }
#define NEGM(t) do { if (BIAS) { const float c_ = cinit<BIAS, VIRT>((t), qw0, lut); if (c_ != c_cur) { c_cur = c_; const float nm_ = c_ - m_reg; _Pragma("unroll") for (int r = 0; r < 16; ++r) negm[r] = nm_; } } } while (0)
  SLOAD(SE, 0); asm volatile("s_waitcnt vmcnt(0)" ::: "memory"); SWRITE(0, SE); __syncthreads();
  qkt<DQK>(pA0, pA1, K_lds, qr, r32, hi, negm); fixup<BIAS, VIRT>(pA0, pA1, 0, L, qw0, r32, hi, lut); partialSM<true>(pA0, pA1, m_reg, alA, negm, c_cur);
  SLOAD(SO, KVBLK); if (SDEPTH == 2) { if (2 < NT) SLOAD(SE, 2 * KVBLK); }
  SWAIT(); SWRITE(1, SO); __syncthreads();
  for (int j = 1; j + 1 < NT; j += 2) {
    NEGM(j); SBAR(); qkt<DQK>(pB0, pB1, K_lds + SHM_K, qr, r32, hi, negm);
    finishSM(pA0, pA1, alA, l_reg, pa0, pa1, pa2, pa3); SBAR();
    SLOAD(SO, (j + SDEPTH) * KVBLK); SBAR();
    pv_d0(o, vb0, pa0, pa1, pa2, pa3); fixup<BIAS, VIRT>(pB0, pB1, j, L, qw0, r32, hi, lut); partialSM<false>(pB0, pB1, m_reg, alB, negm, c_cur);
    __syncthreads(); SWAIT(); SWRITE(0, SE);
    RESC(alB); __syncthreads();
    NEGM(j + 1); SBAR(); qkt<DQK>(pA0, pA1, K_lds, qr, r32, hi, negm);
    finishSM(pB0, pB1, alB, l_reg, pa0, pa1, pa2, pa3); SBAR();
    if (SDEPTH == 1 || j + 3 < NT) SLOAD(SE, (j + 1 + SDEPTH) * KVBLK); SBAR();
    pv_d0(o, vb0 + SHM_V, pa0, pa1, pa2, pa3); fixup<BIAS, VIRT>(pA0, pA1, j + 1, L, qw0, r32, hi, lut); partialSM<false>(pA0, pA1, m_reg, alA, negm, c_cur);
    __syncthreads(); SWAIT(); SWRITE(1, SO);
    RESC(alA); __syncthreads();
  }
  NEGM(NT - 1); SBAR(); qkt<DQK>(pB0, pB1, K_lds + SHM_K, qr, r32, hi, negm);
  finishSM(pA0, pA1, alA, l_reg, pa0, pa1, pa2, pa3); SBAR();
  pv_d0(o, vb0, pa0, pa1, pa2, pa3); fixup<BIAS, VIRT>(pB0, pB1, NT - 1, L, qw0, r32, hi, lut); partialSM<false>(pB0, pB1, m_reg, alB, negm, c_cur);
  __syncthreads(); RESC(alB);
  finishSM(pB0, pB1, alB, l_reg, pa0, pa1, pa2, pa3); SBAR();
  pv_d0(o, vb0 + SHM_V, pa0, pa1, pa2, pa3);
  if (hi == 0) li_l[r32] = l_reg; asm volatile("s_waitcnt lgkmcnt(0)" ::: "memory");
#pragma unroll
  for (int r = 0; r < 16; ++r) { const float rl = __builtin_amdgcn_rcpf(li_l[crow(r, hi)]);
#pragma unroll
    for (int d = 0; d < 4; ++d) o[d][r] *= rl; }
#undef SLOAD
#undef SWRITE
#undef SWAIT
#undef NEGM
#undef RESC
}
}
#define GAS __attribute__((address_space(1)))
#define XB_TMO      128
#define XB_XCNT(j)  (256  + 64 * (j))
#define XB_XSUB(j)  (1280 + 64 * (j))
#define XB_XGEN(j)  (2304 + 64 * (j))
#define XB_TOP      3328
#define XB_TOPGEN   3392
#define XCD_BAR_WORDS 3456
#define XB_SPIN_CAP (1u << 18)

__device__ __forceinline__ unsigned xb_ld(unsigned* p)              { return __hip_atomic_load(p, __ATOMIC_RELAXED, __HIP_MEMORY_SCOPE_AGENT); }
__device__ __forceinline__ unsigned xb_add(unsigned* p, unsigned v) { return __hip_atomic_fetch_add(p, v, __ATOMIC_RELAXED, __HIP_MEMORY_SCOPE_AGENT); }
__device__ __forceinline__ unsigned xb_xcc_id() { return (unsigned)__builtin_amdgcn_s_getreg((3 << 11) | 20) & 0xFu; }
#define XB_SPIN(cond, bar) do { unsigned _sp = 0; while (cond) { __builtin_amdgcn_s_sleep(1); \
    if ((++_sp & 255u) == 0u) { if (xb_ld(&(bar)[XB_TMO])) break; if (_sp > XB_SPIN_CAP) { atomicAdd(&(bar)[XB_TMO], 1u); break; } } } } while (0)

struct XcdBarrier {
    unsigned* bar; unsigned x;
    volatile LAS unsigned* st;
};

__device__ __forceinline__ XcdBarrier xcd_barrier_post(unsigned* bar, volatile LAS unsigned* st) {
    XcdBarrier b; b.bar = bar; b.x = xb_xcc_id(); b.st = st;
    if (threadIdx.x == 0) (void)xb_add(&bar[XB_XCNT(b.x)], 1u);
    return b;
}
__device__ __forceinline__ void xcd_barrier_complete(unsigned* bar, unsigned x, unsigned& nloc, unsigned& nx) {
    const unsigned G = gridDim.x * gridDim.y * gridDim.z;
    unsigned sum, cnt, mine, sp = 0u;
    for (;;) {
        sum = 0u; cnt = 0u; mine = 0u;
#pragma unroll
        for (unsigned j = 0; j < 16; ++j) { const unsigned c = xb_ld(&bar[XB_XCNT(j)]); sum += c; cnt += (c > 0u) ? 1u : 0u; mine = (j == x) ? c : mine; }
        if (sum == G) break;
        __builtin_amdgcn_s_sleep(1);
        if ((++sp & 255u) == 0u) { if (xb_ld(&bar[XB_TMO])) break; if (sp > XB_SPIN_CAP) { atomicAdd(&bar[XB_TMO], 1u); break; } }
    }
    nloc = mine > 0u ? mine : 1u; nx = cnt > 0u ? cnt : 1u;
}

__device__ __forceinline__ void xcd_barrier(const XcdBarrier& b) {
    asm volatile("s_waitcnt vmcnt(0)" ::: "memory");
    __syncthreads();
    if (threadIdx.x == 0) {
        unsigned* bar = b.bar; asm volatile("" : "+s"(bar));
        __builtin_amdgcn_s_waitcnt(0);
        unsigned nloc = b.st[0], nx = b.st[1];
        if (nloc == 0u) { xcd_barrier_complete(bar, b.x, nloc, nx); b.st[0] = nloc; b.st[1] = nx; }
        const unsigned old = xb_add(&bar[XB_XSUB(b.x)], 1u);
        const unsigned gen = old / nloc;
        if (old + 1u == (gen + 1u) * nloc) {
            __builtin_amdgcn_fence(__ATOMIC_RELEASE, "agent");
            asm volatile("s_waitcnt vmcnt(0)" ::: "memory");
            const unsigned og = xb_add(&bar[XB_TOP], 1u);
            const unsigned tg = og / nx;
            if (og + 1u == (tg + 1u) * nx) xb_add(&bar[XB_TOPGEN], 1u);
            else XB_SPIN(xb_ld(&bar[XB_TOPGEN]) == tg, bar);
            __builtin_amdgcn_fence(__ATOMIC_ACQUIRE, "agent");
            xb_add(&bar[XB_XGEN(b.x)], 1u);
            asm volatile("s_waitcnt vmcnt(0)" ::: "memory");
        } else {
            XB_SPIN(xb_ld(&bar[XB_XGEN(b.x)]) == gen, bar);
            __builtin_amdgcn_fence(__ATOMIC_ACQUIRE, "agent");
            asm volatile("s_waitcnt vmcnt(0)" ::: "memory");
        }
    }
    __syncthreads();
}

typedef unsigned short bf16_t;
typedef unsigned v4u __attribute__((ext_vector_type(4)));
typedef float f32x4 __attribute__((ext_vector_type(4)));
constexpr int NWAVES = 8;
constexpr int DM = 2048, DFF = 5632, NIN = 4608, NMETA = 16;
constexpr int LP = 2064, LS = 16400, NTP = 34, NTS = 258;
constexpr int MREAL = 4 * LP + LS, MPAD = 24832, NOUT = 4 * 2048 + 16384, MFULL = 96 * 256, TROWS = MREAL - MFULL  , KSPLIT = 256;
constexpr float EPS = 1e-6f, LOG2E = 1.4426950408889634f;
constexpr float QSCALE_A = 0.125f * LOG2E, QSCALE_B = 0.08838834764831845f * LOG2E;
constexpr size_t MiB = 1u << 20;
constexpr size_t WS_CTL = 0, WS_SS = 1 * MiB, WS_W1IN = 2 * MiB, WS_W1OUT = 46 * MiB, WS_WIN = 68 * MiB, WS_WOUT = 86 * MiB, WS_W2IN = 94 * MiB, WS_W2OUT = 138 * MiB,
                 WS_HB = 160 * MiB, WS_ACT = 257 * MiB, WS_SLAB = 524 * MiB  , WS_END = WS_SLAB + (size_t)(DFF / KSPLIT) * TROWS * DM * 4;
static_assert(WS_ACT + (size_t)MPAD * DFF * 2 <= WS_SLAB, "ws map 2");
static_assert(WS_HB + (size_t)MPAD * DM * 2 <= WS_ACT && 4 * MPAD * 4 <= (int)MiB, "ws map");
constexpr int CW_CNT = 0  , CW_LAM = 1024, CW_LUT = 2048  , CW_BAR = 8192  ;
constexpr size_t CTL_ZERO_BYTES = 65536;
constexpr int QUNITS = 64 + 64 + 2 + 32 + 4 + 36;
constexpr int I_FI = (DM / 64) * (2 * DFF / 64), I_FO = (DFF / 64) * (DM / 64), I_MI = (DM / 64) * (NIN / 64), I_MO = (DM / 64) * (DM / 64);
constexpr int NDEF = I_FI + I_FO + I_MO, NTRU = (NDEF + 63) / 64, CW_TRC = 1536;
constexpr int LDS_BYTES = att::ATT_LDS > pg8::STAGE_BYTES ? att::ATT_LDS : pg8::STAGE_BYTES;
static_assert(8 * 16640 <= LDS_BYTES, "P0 transpose tiles");

#ifndef MK_PHMASK
#define MK_PHMASK 0x3ff
#endif
#define PHON(k) (((MK_PHMASK) >> (k)) & 1)
#ifndef MK_SEQ
#define MK_SEQ 0x9876543210ull
#define MK_NSEQ 10
#endif
#define SWZ(v, pat) __int_as_float(__builtin_amdgcn_ds_swizzle(__float_as_int(v), (pat)))
struct Args { const float* in[17]; float* out; unsigned char* ws; int ph_lo, ph_hi; };

__device__ __forceinline__ unsigned f2bf(float f) { unsigned u = __builtin_bit_cast(unsigned, f); return (u + 0x7fffu + ((u >> 16) & 1u)) >> 16; }
__device__ __forceinline__ unsigned pk2(float lo, float hi) { return f2bf(lo) | (f2bf(hi) << 16); }
__device__ __forceinline__ float wave_sum(float v) {
#define WS_SWZ(x, pat) __int_as_float(__builtin_amdgcn_ds_swizzle(__float_as_int(x), (pat)))
    v += WS_SWZ(v, 0x041F); v += WS_SWZ(v, 0x081F); v += WS_SWZ(v, 0x101F); v += WS_SWZ(v, 0x201F); v += WS_SWZ(v, 0x401F);
#undef WS_SWZ
    auto rr = __builtin_amdgcn_permlane32_swap(__float_as_uint(v), __float_as_uint(v), false, false);
    return __uint_as_float(rr[0]) + __uint_as_float(rr[1]);
}
__device__ __forceinline__ void tr_item(const float* __restrict__ W, int K, int N, bf16_t* __restrict__ WT, const float* __restrict__ gain, int mode, LAS float* scr, int item, int lane) {
    const int nblk = N / 64, kb = item / nblk, nb = item % nblk, k0 = 64 * kb, n0 = 64 * nb;
    int src0 = n0; float cs = 1.f;
    if (mode == 1) { const int pn = n0 >> 8, w = n0 & 255; src0 = (w >> 7) * DFF + pn * 128 + (w & 127); }
    if (mode == 2 && n0 < 1024) cs = QSCALE_A;
    const int lk = lane >> 4, ln = (lane & 15) * 4;
#pragma unroll 8
    for (int i = 0; i < 16; ++i) { const int kk = 4 * i + lk; const float g = gain ? gain[k0 + kk] * cs : cs; const f32x4 v = __builtin_nontemporal_load((const f32x4*)(W + (size_t)(k0 + kk) * N + src0 + ln));
        LAS float* d = scr + kk * 65 + ln; d[0] = v.x * g; d[1] = v.y * g; d[2] = v.z * g; d[3] = v.w * g; }
    asm volatile("s_waitcnt lgkmcnt(0)" ::: "memory");
    const int c = lane >> 3, nn = lane & 7;
#pragma unroll
    for (int j = 0; j < 8; ++j) { const int n = nn + 8 * j; const LAS float* s = scr + (8 * c) * 65 + n;
        v4u o; o.x = pk2(s[0 * 65], s[1 * 65]); o.y = pk2(s[2 * 65], s[3 * 65]); o.z = pk2(s[4 * 65], s[5 * 65]); o.w = pk2(s[6 * 65], s[7 * 65]);
        *(v4u*)(WT + (size_t)(n0 + n) * K + k0 + 8 * c) = o; }
    asm volatile("s_waitcnt lgkmcnt(0)" ::: "memory");
}
__device__ __forceinline__ int t5_bucket(int rel) {
    const int n = rel < 0 ? -rel : rel; const int so = rel > 0 ? 16 : 0;
    int b; if (n < 8) b = n; else if (n < 12) b = 8; else if (n < 16) b = 9; else if (n < 23) b = 10; else if (n < 32) b = 11; else if (n < 46) b = 12; else if (n < 64) b = 13; else if (n < 91) b = 14; else b = 15;
    return so + b;
}

template <int NSL> __device__ __forceinline__ void slab_sum(const float* slab, int row, int c8, f32x4& s0, f32x4& s1) {
    s0 = (f32x4){0.f, 0.f, 0.f, 0.f}; s1 = s0;
    const __attribute__((address_space(1))) float* p = (const __attribute__((address_space(1))) float*)slab + (size_t)row * DM + c8;
#pragma unroll
    for (int s = 0; s < NSL; ++s) { s0 += *(const __attribute__((address_space(1))) f32x4*)(p + (size_t)s * TROWS * DM); s1 += *(const __attribute__((address_space(1))) f32x4*)(p + (size_t)s * TROWS * DM + 4); }
}
typedef const __attribute__((address_space(4))) Args* KArgP;
__device__ __forceinline__ KArgP kargs() { KArgP p = (KArgP)__builtin_amdgcn_kernarg_segment_ptr(); asm volatile("" : "+s"(p)); return p; }
__global__ void __launch_bounds__(NWAVES * 64) fwd_kernel(Args args) {
    extern __shared__ __attribute__((aligned(16))) unsigned char lds[];
    cg::grid_group grid = cg::this_grid();
    { volatile LAS unsigned* m0 = (volatile LAS unsigned*)((LAS unsigned char*)lds + att::OFF_MISC); if (threadIdx.x < 16) m0[threadIdx.x] = 0u; }
    __syncthreads();
    XcdBarrier bar = xcd_barrier_post((unsigned*)(kargs()->ws + WS_CTL) + CW_BAR, (volatile LAS unsigned*)((LAS unsigned char*)lds + att::OFF_MISC) + 8);
    for (int pi = args.ph_lo; pi < args.ph_hi; ++pi) {
        const int ph = (int)((MK_SEQ >> (4 * pi)) & 0xFull);
#define TIDS const int tid = ltid(), lane = tid & 63, wave = __builtin_amdgcn_readfirstlane(tid >> 6), gw = blockIdx.x * NWAVES + wave; (void)tid; (void)lane; (void)gw
        int G = gridDim.x; asm volatile("" : "+s"(G)); const int NGW = G * NWAVES;
        unsigned char* ws = kargs()->ws; asm volatile("" : "+s"(ws));
        unsigned* ctl = (unsigned*)(ws + WS_CTL);
        float* ssb = (float*)(ws + WS_SS);
        bf16_t* HB = (bf16_t*)(ws + WS_HB); bf16_t* ACT = (bf16_t*)(ws + WS_ACT); bf16_t* QKV = ACT; bf16_t* Y = (bf16_t*)kargs()->out;
#define WPTR(off) ((bf16_t*)(ws + (off)))
        if (ph == 0 && PHON(0)) { TIDS;
            LAS float* scr = (LAS float*)((LAS unsigned char*)lds + wave * 16640);
            const float* x_prompt = kargs()->in[0]; const float* x_sample = kargs()->in[1]; const float* meta = kargs()->in[2]; const float* rel_tab = kargs()->in[3];
            constexpr int NITEMS = I_FI + I_FO + I_MI;
            for (int it = gw; it < NITEMS; it += NGW) {
                int r = it;
                if (r < I_FI) { tr_item(kargs()->in[5], DM, 2 * DFF, WPTR(WS_W1IN), kargs()->in[4], 1, scr, r, lane); continue; } r -= I_FI;
                if (r < I_FO) { tr_item(kargs()->in[6], DFF, DM, WPTR(WS_W1OUT), nullptr, 0, scr, r, lane); continue; } r -= I_FO;
                tr_item(kargs()->in[8], DM, NIN, WPTR(WS_WIN), kargs()->in[7], 2, scr, r, lane);
            }
            for (int r = gw; r < MPAD; r += NGW) {
                unsigned long long* o8 = (unsigned long long*)(HB + (size_t)r * DM) + lane; float s2 = 0.f;
                if (r < MREAL) {
                    const int s = r < 4 * LP ? r / LP : 4, t = r < 4 * LP ? r % LP : r - 4 * LP;
                    const float* src = t < NMETA ? meta + (size_t)t * DM : (s < 4 ? x_prompt + ((size_t)s * 2048 + (t - NMETA)) * DM : x_sample + (size_t)(t - NMETA) * DM);
                    const f32x4* xr = (const f32x4*)src + lane;
#pragma unroll
                    for (int j = 0; j < 8; ++j) { const f32x4 v = __builtin_nontemporal_load(xr + 64 * j); s2 += (v.x * v.x + v.y * v.y) + (v.z * v.z + v.w * v.w);
                        o8[64 * j] = (unsigned long long)pk2(v.x, v.y) | ((unsigned long long)pk2(v.z, v.w) << 32); }
                    s2 = wave_sum(s2);
                } else {
#pragma unroll
                    for (int j = 0; j < 8; ++j) o8[64 * j] = 0ull;
                }
                if (lane == 0) ssb[r] = s2;
            }
            for (int i = blockIdx.x * 512 + tid; i < 3 * MPAD; i += G * 512) ssb[MPAD + i] = 0.f;
            for (int i = blockIdx.x * 512 + tid; i < (MPAD - MREAL) * (DM / 8); i += G * 512) { unsigned zz = 0u; asm volatile("" : "+v"(zz)); ((v4u*)(Y + (size_t)MREAL * DM))[i] = (v4u){zz, zz, zz, zz}; }
            if (blockIdx.x == 0) {
                if (tid < 16) ctl[CW_CNT + 64 * tid] = 0u;
                if (wave == 1) { const float* lp = kargs()->in[9]; const float a = wave_sum(lp[lane] * lp[64 + lane]), b = wave_sum(lp[128 + lane] * lp[192 + lane]);
                    if (lane == 0) ((float*)ctl)[CW_LAM] = expf(a) - expf(b) + 0.2f; }
                for (int i = tid; i < 8 * att::LUTN; i += 512) { const int h = i / att::LUTN, rel = i % att::LUTN - att::LUTC; ((float*)ctl)[CW_LUT + i] = rel_tab[t5_bucket(rel) * 8 + h] * LOG2E; }
            }
        } else if ((ph == 1 || ph == 7) && PHON(1)) {
            pg8::Gemm g{HB, ph == 1 ? WPTR(WS_W1IN) : WPTR(WS_W2IN), MPAD, 2 * DFF, DM, DM}; pg8::StaticOrder S; S.init(MPAD, 2 * DFF, G, (int)blockIdx.x);
            pg8::EpiSwiglu E{ACT, ssb + (ph == 1 ? 0 : 2) * MPAD, DFF};
            pg8::gemm_phase<pg8::EpiSwiglu, pg8::StaticOrder, true, true>((LAS unsigned char*)lds, g, S, E);
        } else if ((ph == 2 || ph == 6 || ph == 8) && PHON(2)) {
            const bf16_t* A = ph == 6 ? Y : ACT; const bf16_t* B = ph == 2 ? WPTR(WS_W1OUT) : (ph == 6 ? WPTR(WS_WOUT) : WPTR(WS_W2OUT)); const int K = ph == 6 ? DM : DFF;
            float* ssn = ssb + (ph == 2 ? 1 : (ph == 6 ? 2 : 3)) * MPAD; const float alpha = ph == 6 ? 1.0f : 0.5f;
            { pg8::Gemm g{A, B, MFULL, DM, K, K}; pg8::StaticOrder S; S.init(MFULL, DM, G, (int)blockIdx.x);
              pg8::EpiResid E{HB, ssn, alpha};
              pg8::gemm_phase<pg8::EpiResid, pg8::StaticOrder, true, true>((LAS unsigned char*)lds, g, S, E); }
            float* slab = (float*)(ws + WS_SLAB);
            { pg8::Gemm g{A + (size_t)MFULL * K, B, 256, DM, K, KSPLIT}; pg8::SplitOrder S; S.init(DM, K / KSPLIT, KSPLIT, G, (int)blockIdx.x);
              pg8::EpiSlab E{slab, TROWS};
              pg8::gemm_phase<pg8::EpiSlab, pg8::SplitOrder, true, true>((LAS unsigned char*)lds, g, S, E); }
            xcd_barrier(bar);
            { const int ltid_ = ltid(), wave_ = __builtin_amdgcn_readfirstlane(ltid_ >> 6);
              for (int wt = wave_ * G + (int)blockIdx.x; wt < TROWS * (DM / 8) / 64; wt += G * NWAVES) { const int i = wt * 64 + (ltid_ & 63); const int row = i / (DM / 8), c8 = (i % (DM / 8)) * 8;
                  f32x4 s0, s1;
                  if (K == DFF) slab_sum<DFF / KSPLIT>(slab, row, c8, s0, s1); else slab_sum<DM / KSPLIT>(slab, row, c8, s0, s1);
                  bf16_t* hp = HB + (size_t)(MFULL + row) * DM + c8; const v4u h = *(const v4u*)hp;
                  const float n0 = pg8::bf_lo(h.x) + alpha * s0.x, n1 = pg8::bf_hi(h.x) + alpha * s0.y, n2 = pg8::bf_lo(h.y) + alpha * s0.z, n3 = pg8::bf_hi(h.y) + alpha * s0.w;
                  const float n4 = pg8::bf_lo(h.z) + alpha * s1.x, n5 = pg8::bf_hi(h.z) + alpha * s1.y, n6 = pg8::bf_lo(h.w) + alpha * s1.z, n7 = pg8::bf_hi(h.w) + alpha * s1.w;
                  v4u w; w.x = pk2(n0, n1); w.y = pk2(n2, n3); w.z = pk2(n4, n5); w.w = pk2(n6, n7); *(v4u*)hp = w;
                  const float sq = wave_sum((n0 * n0 + n1 * n1) + (n2 * n2 + n3 * n3) + (n4 * n4 + n5 * n5) + (n6 * n6 + n7 * n7));
                  if ((ltid_ & 63) == 0) atomicAdd(ssn + MFULL + row, sq); } }
        } else if (ph == 3 && PHON(3)) {
            pg8::Gemm g{HB, WPTR(WS_WIN), MPAD, NIN, DM, DM}; pg8::StaticOrder S; S.init(MPAD, NIN, G, (int)blockIdx.x);
            pg8::EpiScale E{QKV, ssb + MPAD, NIN};
            pg8::gemm_phase<pg8::EpiScale, pg8::StaticOrder, true, true>((LAS unsigned char*)lds, g, S, E);
        } else if (ph == 4 && PHON(4)) { TIDS;
            const float* qkg = kargs()->in[11];
            for (int r = gw; r < MREAL; r += NGW) {
                const int t = r < 4 * LP ? r % LP : r - 4 * LP;
                float c = 1.f, sn = 0.f;
                if (t >= NMETA) { const int pp = t - NMETA, rowi = pp >> 6, coli = pp & 63;
                    const float f = __builtin_amdgcn_exp2f(-(float)(lane & 31) * (13.287712379549449f / 32.0f));
                    const float ang = (float)(lane < 32 ? rowi : coli) * f; float rev = ang * 0.15915494309189535f; rev -= floorf(rev);
                    sn = __builtin_amdgcn_sinf(rev); c = __builtin_amdgcn_cosf(rev); }
                bf16_t* base = QKV + (size_t)r * NIN;
                unsigned wv[10];
#pragma unroll
                for (int hh = 0; hh < 10; ++hh) wv[hh] = *((const unsigned*)(base + (hh < 8 ? 3072 + hh * 128 : 4096 + (hh - 8) * 128)) + lane);
                const float gq0 = qkg[2 * lane], gq1 = qkg[2 * lane + 1], gk0 = qkg[128 + 2 * lane], gk1 = qkg[128 + 2 * lane + 1];
#pragma unroll
                for (int hh = 0; hh < 10; ++hh) { const int off = hh < 8 ? 3072 + hh * 128 : 4096 + (hh - 8) * 128; const float qs = hh < 8 ? QSCALE_B : 1.f;
                    const float x0 = pg8::bf_lo(wv[hh]), x1 = pg8::bf_hi(wv[hh]);
                    const float s2 = wave_sum(x0 * x0 + x1 * x1); const float rn = __builtin_amdgcn_rsqf(s2 * (1.0f / 128.0f) + EPS);
                    const float y0 = x0 * rn * (hh < 8 ? gq0 : gk0), y1 = x1 * rn * (hh < 8 ? gq1 : gk1);
                    *((unsigned*)(base + off) + lane) = pk2((y0 * c - y1 * sn) * qs, (y0 * sn + y1 * c) * qs); }
            }
        } else if (ph == 5 && PHON(5)) { TIDS;
            char* L = (char*)lds; int* misc = (int*)(L + att::OFF_MISC); float* lut = (float*)(L + att::OFF_LUT);
            const int home = (int)((unsigned)__builtin_amdgcn_s_getreg((3 << 11) | 20) & 7u);
            const float lam = ((const float*)ctl)[CW_LAM];
            for (int qq = 0; qq < 8; ++qq) { const int queue = (home + qq) & 7;
                for (;;) {
                    __syncthreads();
                    if (ltid() == 0) misc[0] = (int)atomicAdd(ctl + CW_CNT + 64 * (queue + 8 * (pi & 1)), 1u);
                    __syncthreads();
                    const int ui = misc[0]; if (ui >= QUNITS) break;
                    int seq, head, qb;
                    bool virt = false;
                    if (ui < 64) { seq = 4; head = queue; qb = ui; } else if (ui < 128) { seq = 4; head = 8 + queue; qb = ui - 64; }
                    else if (ui == 128) { seq = 4; head = queue; qb = 64; virt = true; } else if (ui == 129) { seq = 4; head = 8 + queue; qb = 64; }
                    else if (ui < 162) { const int j = ui - 130; seq = j >> 3; qb = j & 7; head = queue; } else if (ui < 166) { seq = ui - 162; qb = 8; head = queue; virt = true; }
                    else { const int j = ui - 166; seq = j / 9; qb = j % 9; head = 8 + queue; }
                    const int rowbase = seq * LP, Lk = seq < 4 ? LP : LS, NT = seq < 4 ? NTP : NTS, q0 = qb * 256, qw0 = q0 + wave * 32;
                    const int nact = min(8, (Lk - q0 + 31) >> 5);
                    const bf16_t* Qs = QKV + (size_t)rowbase * NIN; bf16_t* Ys = Y + (size_t)rowbase * DM;
                    att::f32x16 o[4];
                    if (virt) {
                        for (int i = ltid(); i < att::LUTN; i += 512) lut[i] = ((const float*)ctl)[CW_LUT + head * att::LUTN + i];
                        __syncthreads();
                        att::attn_pass<128, true, true>(Qs + (size_t)q0 * NIN + head * 128, Qs + 1024 + head * 128, Qs + 2048 + head * 128, Lk, NT, q0, lut, o, L, 1);
                        if (wave == 0) { const int le_ = ltid() & 63, r32 = le_ & 31, hi = le_ >> 5;
                            const float* sg = kargs()->in[10];
                            float g4[4];
#pragma unroll
                            for (int d = 0; d < 4; ++d) g4[d] = sg[d * 32 + r32] * 0.8f;
#pragma unroll
                            for (int r = 0; r < 8; ++r) {
                                float dv[4];
#pragma unroll
                                for (int d = 0; d < 4; ++d) dv[d] = o[d][r] - lam * o[d][r + 8];
                                float s2 = (dv[0] * dv[0] + dv[1] * dv[1]) + (dv[2] * dv[2] + dv[3] * dv[3]);
                                s2 += SWZ(s2, 0x041F); s2 += SWZ(s2, 0x081F); s2 += SWZ(s2, 0x101F); s2 += SWZ(s2, 0x201F); s2 += SWZ(s2, 0x401F);
                                const float rn = __builtin_amdgcn_rsqf(s2 * (1.0f / 128.0f) + EPS); const int row = q0 + att::crow(r, hi);
                                if (row < Lk) { bf16_t* yp = Ys + (size_t)row * DM + head * 128 + r32;
#pragma unroll
                                    for (int d = 0; d < 4; ++d) ((__attribute__((address_space(1))) bf16_t*)yp)[d * 32] = (bf16_t)f2bf(dv[d] * rn * g4[d]); } } }
                    } else if (head < 8) {
                        for (int i = ltid(); i < att::LUTN; i += 512) lut[i] = ((const float*)ctl)[CW_LUT + head * att::LUTN + i];
#pragma unroll 1
                        for (int pass = 0; pass < 2; ++pass) {
                            __syncthreads();
                            att::attn_pass<64, true>(Qs + (size_t)q0 * NIN + head * 128 + pass * 64, Qs + 1024 + head * 128 + pass * 64, Qs + 2048 + head * 128, Lk, NT, qw0, lut, o, L, nact);
                            if (pass == 0) { unsigned* st = (unsigned*)(L + att::OFF_O1) + wave * 2048 + (ltid() & 63);
#pragma unroll
                                for (int d = 0; d < 4; ++d)
#pragma unroll
                                    for (int r = 0; r < 16; r += 2) st[(d * 8 + (r >> 1)) * 64] = att::cvtpk(o[d][r], o[d][r + 1]);
                            }
                        }
                        asm volatile("s_waitcnt lgkmcnt(0)" ::: "memory");
                        const int le_ = ltid() & 63, r32 = le_ & 31, hi = le_ >> 5;
                        const float* sg = kargs()->in[10]; const unsigned* st = (const unsigned*)(L + att::OFF_O1) + wave * 2048 + (ltid() & 63);
#pragma unroll
                        for (int d = 0; d < 4; ++d)
#pragma unroll
                            for (int r = 0; r < 16; r += 2) { const unsigned w = st[(d * 8 + (r >> 1)) * 64]; o[d][r] = pg8::bf_lo(w) - lam * o[d][r]; o[d][r + 1] = pg8::bf_hi(w) - lam * o[d][r + 1]; }
                        float g4[4];
#pragma unroll
                        for (int d = 0; d < 4; ++d) g4[d] = sg[d * 32 + r32] * 0.8f;
#pragma unroll
                        for (int r = 0; r < 16; ++r) { float s2 = (o[0][r] * o[0][r] + o[1][r] * o[1][r]) + (o[2][r] * o[2][r] + o[3][r] * o[3][r]);
                            s2 += SWZ(s2, 0x041F); s2 += SWZ(s2, 0x081F); s2 += SWZ(s2, 0x101F); s2 += SWZ(s2, 0x201F); s2 += SWZ(s2, 0x401F);
                            const float rn = __builtin_amdgcn_rsqf(s2 * (1.0f / 128.0f) + EPS); const int row = qw0 + att::crow(r, hi);
                            if (row < Lk) { bf16_t* yp = Ys + (size_t)row * DM + head * 128 + r32;
#pragma unroll
                                for (int d = 0; d < 4; ++d) ((__attribute__((address_space(1))) bf16_t*)yp)[d * 32] = (bf16_t)f2bf(o[d][r] * rn * g4[d]); } }
                    } else {
                        const int hq = head - 8, kvh = hq >> 2;
                        __syncthreads();
                        att::attn_pass<128, false>(Qs + (size_t)q0 * NIN + 3072 + hq * 128, Qs + 4096 + kvh * 128, Qs + 4352 + kvh * 128, Lk, NT, qw0, lut, o, L, nact);
                        const int le_ = ltid() & 63, r32 = le_ & 31, hi = le_ >> 5;
#pragma unroll
                        for (int r = 0; r < 16; ++r) { const int row = qw0 + att::crow(r, hi);
                            if (row < Lk) { bf16_t* yp = Ys + (size_t)row * DM + 1024 + hq * 128 + r32;
#pragma unroll
                                for (int d = 0; d < 4; ++d) ((__attribute__((address_space(1))) bf16_t*)yp)[d * 32] = (bf16_t)f2bf(o[d][r]); } }
                    }
                }
            }
            { const int lane2 = ltid() & 63; LAS float* scr = (LAS float*)((LAS unsigned char*)lds + wave * 16640); int* misc2 = (int*)((char*)lds + att::OFF_MISC);
              for (;;) {
                  __syncthreads();
                  if (ltid() == 0) misc2[0] = (int)atomicAdd(ctl + CW_TRC, 1u);
                  __syncthreads();
                  const int tu = misc2[0]; if (tu >= NTRU) break;
                  const int base = tu * 64 + wave * 8;
                  for (int k = 0; k < 8; ++k) { int r = base + k; if (r >= NDEF) break;
                      if (r < I_FI) { tr_item(kargs()->in[14], DM, 2 * DFF, WPTR(WS_W2IN), kargs()->in[13], 1, scr, r, lane2); continue; } r -= I_FI;
                      if (r < I_FO) { tr_item(kargs()->in[15], DFF, DM, WPTR(WS_W2OUT), nullptr, 0, scr, r, lane2); continue; } r -= I_FO;
                      tr_item(kargs()->in[12], DM, DM, WPTR(WS_WOUT), nullptr, 0, scr, r, lane2); } } }
        } else if (ph == 9 && PHON(9)) { TIDS;
            const float* fg = kargs()->in[16]; const float* ss3 = ssb + 3 * MPAD;
            for (int ro = gw; ro < NOUT; ro += NGW) {
                const int s = ro < 8192 ? ro >> 11 : 4, r = ro + NMETA * (s + 1);
                const float ri = __builtin_amdgcn_rsqf(ss3[r] * (1.0f / 2048.0f) + EPS);
                const v4u* hp = (const v4u*)(HB + (size_t)r * DM) + lane; float* op = kargs()->out + (size_t)ro * DM + 8 * lane; const float* gp = fg + 8 * lane;
#pragma unroll
                for (int j = 0; j < 4; ++j) { const v4u h = __builtin_nontemporal_load(hp + 64 * j); const f32x4 g0 = *(const f32x4*)(gp + 512 * j), g1 = *(const f32x4*)(gp + 512 * j + 4);
                    f32x4 a, b; a.x = pg8::bf_lo(h.x) * ri * g0.x; a.y = pg8::bf_hi(h.x) * ri * g0.y; a.z = pg8::bf_lo(h.y) * ri * g0.z; a.w = pg8::bf_hi(h.y) * ri * g0.w;
                    b.x = pg8::bf_lo(h.z) * ri * g1.x; b.y = pg8::bf_hi(h.z) * ri * g1.y; b.z = pg8::bf_lo(h.w) * ri * g1.z; b.w = pg8::bf_hi(h.w) * ri * g1.w;
                    __builtin_nontemporal_store(a, (f32x4*)(op + 512 * j)); __builtin_nontemporal_store(b, (f32x4*)(op + 512 * j + 4)); }
            }
        }
        if (pi + 1 < args.ph_hi) { if (args.ph_lo > 4096) grid.sync();   xcd_barrier(bar); }
    }
}

extern "C" void kernel_launch(void* const* d_in, const int* in_sizes, int n_in, void* d_out, int out_size, void* d_ws, size_t ws_size, hipStream_t stream) {
    static int grid = 0;
    if (grid == 0) {
        if (n_in != 17 || out_size != NOUT * DM || ws_size < WS_END) { fprintf(stderr, "kernel_launch: unexpected shapes (n_in %d out %d ws %zu need %zu)\n", n_in, out_size, ws_size, (size_t)WS_END); grid = -1; return; }
        int dev = 0, cus = 0, per_cu = 0;
        hipGetDevice(&dev); hipDeviceGetAttribute(&cus, hipDeviceAttributeMultiprocessorCount, dev);
        if (hipFuncSetAttribute((const void*)fwd_kernel, hipFuncAttributeMaxDynamicSharedMemorySize, LDS_BYTES) != hipSuccess) { fprintf(stderr, "kernel_launch: hipFuncSetAttribute failed\n"); grid = -1; return; }
        if (hipOccupancyMaxActiveBlocksPerMultiprocessor(&per_cu, (const void*)fwd_kernel, NWAVES * 64, LDS_BYTES) != hipSuccess || per_cu < 1) { fprintf(stderr, "kernel_launch: occupancy query says %d\n", per_cu); per_cu = 1; }
        (void)hipGetLastError();
        grid = cus * 1;
    }
    if (grid < 0) return;
    if (hipMemsetAsync((char*)d_ws + WS_CTL, 0, CTL_ZERO_BYTES, stream) != hipSuccess) { fprintf(stderr, "kernel_launch: memset failed\n"); return; }
    Args a{};
    for (int i = 0; i < 17; ++i) a.in[i] = (const float*)d_in[i];
    a.out = (float*)d_out; a.ws = (unsigned char*)d_ws;
#if MK_PER_PHASE
    for (int ph = 0; ph < MK_NSEQ; ++ph) { a.ph_lo = ph; a.ph_hi = ph + 1; hipLaunchKernelGGL(fwd_kernel, dim3(grid), dim3(NWAVES * 64), LDS_BYTES, stream, a); }
#else
    a.ph_lo = 0; a.ph_hi = MK_NSEQ;
    void* kargs[] = {&a};
    hipError_t e = hipLaunchCooperativeKernel((const void*)fwd_kernel, dim3(grid), dim3(NWAVES * 64), kargs, LDS_BYTES, stream);
    if (e != hipSuccess) fprintf(stderr, "kernel_launch: cooperative launch failed: %s (grid %d)\n", hipGetErrorString(e), grid);
#endif
}
```
